# Optimizing an MI355X kernel written in HIP

```python
import jax, jax.numpy as jnp
from jax import lax
import numpy as np

D_MODEL = 1024
BATCH = 4
SEQ = 4096
DEPTH = 1

MEM_LEN = 256
POOL_WINDOWS = (2, 4, 8, 16)
POOL_GROUPS = 4
POOL_GROUP_DIM = D_MODEL // 8
POOL_WIDTH = POOL_GROUPS * POOL_GROUP_DIM
RET_HEADS = 4
RET_QK_DIM = D_MODEL // 8
RET_V_DIM = D_MODEL // 4
RET_QK_WIDTH = RET_HEADS * RET_QK_DIM
RET_V_WIDTH = RET_HEADS * RET_V_DIM
RET_CHUNK = 128
ROPE_BASE = 10000.0
XA_HEADS = 4
XA_HEAD_DIM = D_MODEL // 8
XA_WIDTH = XA_HEADS * XA_HEAD_DIM
N_BRANCHES = 3
IN_WIDTHS = (POOL_WIDTH, RET_QK_WIDTH, RET_QK_WIDTH, RET_V_WIDTH, RET_V_WIDTH, XA_WIDTH, N_BRANCHES * D_MODEL)
N_GROUPS = 4
EXPERTS_PER_GROUP = 8
TOP_K = 2
D_EXPERT = D_MODEL // 4
LN_EPS = 1e-5
ALPHA = (2.0 * DEPTH) ** 0.25
BETA = (8.0 * DEPTH) ** -0.25

kernel_name = 'hybrid_pool_retention_memory_hmoe'


def layer_norm(x, w, b):
    xf = x.astype(jnp.float32)
    mu = jnp.mean(xf, axis=-1, keepdims=True)
    xc = xf - mu
    var = jnp.mean(xc * xc, axis=-1, keepdims=True)
    return (xc * lax.rsqrt(var + LN_EPS) * w + b).astype(x.dtype)


def head_group_norm(y, w):
    mu = jnp.mean(y, axis=-1, keepdims=True)
    yc = y - mu
    var = jnp.mean(yc * yc, axis=-1, keepdims=True)
    return yc * lax.rsqrt(var + LN_EPS) * w


def multiscale_pool(u, w_grp, scale):
    B, S, _ = u.shape
    uf = u.astype(jnp.float32)
    csum = jnp.pad(jnp.cumsum(uf, axis=1), ((0, 0), (1, 0), (0, 0)))
    hi = jnp.arange(1, S + 1)
    outs = []
    for g, w in enumerate(POOL_WINDOWS):
        sl = slice(g * POOL_GROUP_DIM, (g + 1) * POOL_GROUP_DIM)
        lo = jnp.maximum(hi - w, 0)
        cnt = (hi - lo).astype(jnp.float32)[None, :, None]
        mean = (csum[:, 1:, sl] - csum[:, lo, sl]) / cnt
        outs.append(mean - uf[:, :, sl])
    pooled = jnp.stack(outs, axis=2)
    mixed = jnp.einsum('bsgc,gcd->bsgd', pooled, w_grp.astype(jnp.float32))
    return (mixed.reshape(B, S, POOL_WIDTH) * scale).astype(u.dtype)


def rotary(x, positions):
    d = x.shape[-1]
    inv_freq = ROPE_BASE ** (-jnp.arange(d // 2, dtype=jnp.float32) / (d // 2))
    ang = positions.astype(jnp.float32)[:, :, None, None] * inv_freq
    cos, sin = jnp.cos(ang), jnp.sin(ang)
    xf = x.astype(jnp.float32)
    x1, x2 = xf[..., : d // 2], xf[..., d // 2:]
    return jnp.concatenate([x1 * cos - x2 * sin, x2 * cos + x1 * sin], axis=-1)


def retention(q, k, v):
    B, S, H, dk = q.shape
    dv = v.shape[-1]
    C = RET_CHUNK
    N = S // C
    log_gamma = jnp.log1p(-jnp.exp2(-5.0 - jnp.arange(H, dtype=jnp.float32)))
    qc = q.astype(jnp.float32).reshape(B, N, C, H, dk)
    kc = (k.astype(jnp.float32) * dk ** -0.5).reshape(B, N, C, H, dk)
    vc = v.astype(jnp.float32).reshape(B, N, C, H, dv)
    pos = jnp.arange(C, dtype=jnp.float32)
    diff = pos[:, None] - pos[None, :]
    intra_decay = jnp.where(diff >= 0, jnp.exp(log_gamma[:, None, None] * jnp.maximum(diff, 0.0)), 0.0)
    scores = jnp.einsum('bnchd,bnshd->bnhcs', qc, kc) * intra_decay
    intra = jnp.einsum('bnhcs,bnshe->bnche', scores, vc)
    k_decay = jnp.exp(log_gamma[:, None] * (C - 1.0 - pos)[None, :])
    kv = jnp.einsum('bnshd,hs,bnshe->nbhde', kc, k_decay, vc)
    chunk_decay = jnp.exp(log_gamma * C)[None, :, None, None]

    def step(state, kv_n):
        return chunk_decay * state + kv_n, state

    _, prev = lax.scan(step, jnp.zeros((B, H, dk, dv), jnp.float32), kv)
    q_decay = jnp.exp(log_gamma[:, None] * (pos + 1.0)[None, :])
    cross = jnp.einsum('bnchd,hc,nbhde->bnche', qc, q_decay, prev)
    return (intra + cross).reshape(B, S, H, dv)


def memory_cross_attention(q, mem, w_mem_kv):
    B, S, _ = q.shape
    kv = mem @ w_mem_kv
    k, v = jnp.split(kv, 2, axis=-1)
    qh = q.reshape(B, S, XA_HEADS, XA_HEAD_DIM)
    kh = k.reshape(B, -1, XA_HEADS, XA_HEAD_DIM)
    vh = v.reshape(B, -1, XA_HEADS, XA_HEAD_DIM)
    s = jnp.einsum('bshd,bmhd->bhsm', qh, kh).astype(jnp.float32) * XA_HEAD_DIM ** -0.5
    p = jax.nn.softmax(s, axis=-1).astype(vh.dtype)
    o = jnp.einsum('bhsm,bmhd->bshd', p, vh)
    return o.reshape(B, S, XA_WIDTH)


def hierarchical_moe(h, w_grp_router, b_grp_router, w_exp_router, b_exp_router, w_gate, w_up, w_down):
    B, S, D = h.shape
    t = h.reshape(B * S, D)
    grp_prob = jax.nn.softmax((t @ w_grp_router).astype(jnp.float32) + b_grp_router, axis=-1)
    p_grp, grp_sel = lax.top_k(grp_prob, 1)
    grp_onehot = jax.nn.one_hot(grp_sel[:, 0], N_GROUPS, dtype=jnp.float32)
    exp_logits = ((t @ w_exp_router).astype(jnp.float32) + b_exp_router).reshape(-1, N_GROUPS, EXPERTS_PER_GROUP)
    exp_logits = jnp.einsum('tge,tg->te', exp_logits, grp_onehot)
    top_v, top_i = lax.top_k(exp_logits, TOP_K)
    top_w = jax.nn.softmax(top_v, axis=-1) * p_grp
    w_in_grp = jnp.einsum('tk,tke->te', top_w, jax.nn.one_hot(top_i, EXPERTS_PER_GROUP, dtype=jnp.float32))
    gate = (grp_onehot[:, :, None] * w_in_grp[:, None, :]).astype(h.dtype)
    out = jnp.zeros_like(t)
    for g in range(N_GROUPS):
        a = jnp.einsum('td,edf->tef', t, w_gate[g])
        b = jnp.einsum('td,edf->tef', t, w_up[g])
        act = jax.nn.silu(a) * b * gate[:, g, :, None]
        out = out + jnp.einsum('tef,efd->td', act, w_down[g])
    return out.reshape(B, S, D)


def setup_inputs(seed: int = 0) -> dict:
    key = jax.random.key(seed)
    ks = jax.random.split(key, 24)
    f32 = jnp.float32

    def nrm(k, shape, fan_in, gain=1.0):
        return jax.random.normal(k, shape, f32) * (gain * fan_in ** -0.5)

    x = jax.random.normal(ks[0], (BATCH, SEQ, D_MODEL), f32)
    mem = jax.random.normal(ks[1], (BATCH, MEM_LEN, D_MODEL), f32)
    positions = jnp.arange(SEQ, dtype=jnp.int32)[None, :] + jax.random.randint(ks[2], (BATCH, 1), 0, 1024, dtype=jnp.int32)
    in_keys = jax.random.split(ks[3], len(IN_WIDTHS))
    in_gains = (1.0, 1.0, 1.0, BETA, 1.0, 1.0, 1.0)
    w_in = jnp.concatenate([nrm(k, (DEPTH, D_MODEL, w), D_MODEL, g) for k, w, g in zip(in_keys, IN_WIDTHS, in_gains)], axis=-1)
    w_pool_grp = nrm(ks[4], (DEPTH, POOL_GROUPS, POOL_GROUP_DIM, POOL_GROUP_DIM), POOL_GROUP_DIM)
    pool_scale = 0.5 + 0.05 * jax.random.normal(ks[5], (DEPTH, POOL_WIDTH), f32)
    ret_gn_w = 1.0 + 0.02 * jax.random.normal(ks[6], (DEPTH, RET_HEADS, RET_V_DIM), f32)
    w_mem_kv = jnp.concatenate([nrm(ks[7], (DEPTH, D_MODEL, XA_WIDTH), D_MODEL),
                                nrm(ks[8], (DEPTH, D_MODEL, XA_WIDTH), D_MODEL, BETA)], axis=-1)
    w_br_pool = nrm(ks[9], (DEPTH, POOL_WIDTH, D_MODEL), POOL_WIDTH)
    w_br_ret = nrm(ks[10], (DEPTH, RET_V_WIDTH, D_MODEL), RET_V_WIDTH)
    w_br_xa = nrm(ks[11], (DEPTH, XA_WIDTH, D_MODEL), XA_WIDTH)
    w_out = nrm(ks[12], (DEPTH, D_MODEL, D_MODEL), D_MODEL, BETA)
    ln1_w = 1.0 + 0.02 * jax.random.normal(ks[13], (DEPTH, D_MODEL), f32)
    ln1_b = 0.02 * jax.random.normal(ks[14], (DEPTH, D_MODEL), f32)
    w_grp_router = nrm(ks[15], (DEPTH, D_MODEL, N_GROUPS), D_MODEL)
    b_grp_router = 0.01 * jax.random.normal(ks[16], (DEPTH, N_GROUPS), f32)
    w_exp_router = nrm(ks[17], (DEPTH, D_MODEL, N_GROUPS * EXPERTS_PER_GROUP), D_MODEL)
    b_exp_router = 0.01 * jax.random.normal(ks[18], (DEPTH, N_GROUPS * EXPERTS_PER_GROUP), f32)
    w_exp_gate = nrm(ks[19], (DEPTH, N_GROUPS, EXPERTS_PER_GROUP, D_MODEL, D_EXPERT), D_MODEL)
    w_exp_up = nrm(ks[20], (DEPTH, N_GROUPS, EXPERTS_PER_GROUP, D_MODEL, D_EXPERT), D_MODEL)
    w_exp_down = nrm(ks[21], (DEPTH, N_GROUPS, EXPERTS_PER_GROUP, D_EXPERT, D_MODEL), D_EXPERT, BETA)
    ln2_w = 1.0 + 0.02 * jax.random.normal(ks[22], (DEPTH, D_MODEL), f32)
    ln2_b = 0.02 * jax.random.normal(ks[23], (DEPTH, D_MODEL), f32)
    return {'x': x, 'mem': mem, 'positions': positions, 'w_in': w_in, 'w_pool_grp': w_pool_grp,
            'pool_scale': pool_scale, 'ret_gn_w': ret_gn_w, 'w_mem_kv': w_mem_kv, 'w_br_pool': w_br_pool,
            'w_br_ret': w_br_ret, 'w_br_xa': w_br_xa, 'w_out': w_out, 'ln1_w': ln1_w, 'ln1_b': ln1_b,
            'w_grp_router': w_grp_router, 'b_grp_router': b_grp_router, 'w_exp_router': w_exp_router,
            'b_exp_router': b_exp_router, 'w_exp_gate': w_exp_gate, 'w_exp_up': w_exp_up,
            'w_exp_down': w_exp_down, 'ln2_w': ln2_w, 'ln2_b': ln2_b}


def reference(x, mem, positions, w_in, w_pool_grp, pool_scale, ret_gn_w, w_mem_kv, w_br_pool, w_br_ret,
              w_br_xa, w_out, ln1_w, ln1_b, w_grp_router, b_grp_router, w_exp_router, b_exp_router,
              w_exp_gate, w_exp_up, w_exp_down, ln2_w, ln2_b):
    B, S, _ = x.shape
    split_points = [int(p) for p in np.cumsum(IN_WIDTHS)[:-1]]
    for l in range(DEPTH):
        proj = x @ w_in[l]
        u_pool, r_q, r_k, r_v, r_g, xa_q, gate_logits = jnp.split(proj, split_points, axis=-1)
        y_pool = multiscale_pool(u_pool, w_pool_grp[l], pool_scale[l])
        q = rotary(r_q.reshape(B, S, RET_HEADS, RET_QK_DIM), positions)
        k = rotary(r_k.reshape(B, S, RET_HEADS, RET_QK_DIM), positions)
        y_ret = retention(q, k, r_v.reshape(B, S, RET_HEADS, RET_V_DIM))
        y_ret = head_group_norm(y_ret, ret_gn_w[l]).reshape(B, S, RET_V_WIDTH)
        y_ret = (jax.nn.silu(r_g.astype(jnp.float32)) * y_ret).astype(x.dtype)
        y_xa = memory_cross_attention(xa_q, mem, w_mem_kv[l])
        g = jax.nn.sigmoid(gate_logits.astype(jnp.float32)).astype(x.dtype).reshape(B, S, N_BRANCHES, D_MODEL)
        merged = (g[:, :, 0] * (y_pool @ w_br_pool[l])
                  + g[:, :, 1] * (y_ret @ w_br_ret[l])
                  + g[:, :, 2] * (y_xa @ w_br_xa[l]))
        x = layer_norm(ALPHA * x + merged @ w_out[l], ln1_w[l], ln1_b[l])
        moe = hierarchical_moe(x, w_grp_router[l], b_grp_router[l], w_exp_router[l], b_exp_router[l],
                               w_exp_gate[l], w_exp_up[l], w_exp_down[l])
        x = layer_norm(ALPHA * x + moe, ln2_w[l], ln2_b[l])
    return x
```

```cpp
#include <hip/hip_runtime.h>
#include <stdint.h>
#include <math.h>

typedef unsigned short bf16_t;
__device__ __forceinline__ float bf2f(bf16_t h) { return __uint_as_float(((unsigned)h) << 16); }
__device__ __forceinline__ bf16_t f2bf(float f) { unsigned u = __float_as_uint(f); return (bf16_t)((u + 0x7fffu + ((u >> 16) & 1u)) >> 16); }

constexpr int D = 1024, BATCH = 4, SEQ = 4096, T = BATCH * SEQ, MEML = 256;
constexpr int NIN = 7168;
constexpr int CH = 128, NCH = SEQ / CH;
constexpr int NEXP = 32, DEXP = 256;
constexpr float LN_EPS = 1e-5f;
constexpr float ALPHA = 1.189207115002721f;
constexpr size_t MiB = 1u << 20;
constexpr size_t WS_CTL = 0, WS_TOKINFO = 1 * MiB, WS_LISTS = 2 * MiB;
constexpr size_t WS_MEMK = 11 * MiB, WS_MEMV = 12 * MiB, WS_POOLED = 13 * MiB;
constexpr size_t WS_UPOOL = 32 * MiB, WS_Q = 48 * MiB, WS_K = 64 * MiB, WS_V = 80 * MiB, WS_G = 112 * MiB, WS_XQ = 144 * MiB, WS_GATES = 160 * MiB;
constexpr size_t WS_MERGED = 48 * MiB, WS_X1B = 80 * MiB, WS_ACT = 32 * MiB, WS_TMP = 52 * MiB, WS_Y = 176 * MiB;
constexpr int CW_CNT = 1024;
constexpr int CW_BASE = 1088;

template <typename TA> __device__ __forceinline__ float ldA(const TA* p);
template <> __device__ __forceinline__ float ldA<float>(const float* p) { return *p; }
template <> __device__ __forceinline__ float ldA<bf16_t>(const bf16_t* p) { return bf2f(*p); }

template <typename TA, typename Epi>
__global__ __launch_bounds__(256) void gemm_naive(const TA* __restrict__ A, int lda, const int* __restrict__ rowidx, int ridx_zs,
                                                  const int* __restrict__ Mptr, int M, const int* __restrict__ arow0,
                                                  const float* __restrict__ B, int ldb, size_t b_zs, int N, int K, Epi epi) {
    __shared__ float As[16][65];
    __shared__ float Bs[16][64];
    const int z = blockIdx.z;
    const int Mz = Mptr ? Mptr[z] : M;
    const int r0 = blockIdx.y * 64, c0 = blockIdx.x * 64;
    if (r0 >= Mz) return;
    const int tid = threadIdx.x, ty = tid >> 4, tx = tid & 15;
    const float* Bz = B + (size_t)z * b_zs;
    float acc[4][4] = {};
    for (int k0 = 0; k0 < K; k0 += 16) {
#pragma unroll
        for (int i = 0; i < 4; ++i) {
            const int idx = tid + i * 256, r = idx >> 4, kk = idx & 15;
            float v = 0.f;
            if (r0 + r < Mz) {
                const int row = rowidx ? rowidx[(size_t)z * ridx_zs + r0 + r] : (arow0 ? arow0[z] : 0) + r0 + r;
                v = ldA<TA>(A + (size_t)row * lda + k0 + kk);
            }
            As[kk][r] = v;
        }
#pragma unroll
        for (int i = 0; i < 4; ++i) {
            const int idx = tid + i * 256, kk = idx >> 6, n = idx & 63;
            Bs[kk][n] = Bz[(size_t)(k0 + kk) * ldb + c0 + n];
        }
        __syncthreads();
#pragma unroll
        for (int kk = 0; kk < 16; ++kk) {
            float a[4], b[4];
#pragma unroll
            for (int i = 0; i < 4; ++i) a[i] = As[kk][ty * 4 + i];
#pragma unroll
            for (int j = 0; j < 4; ++j) b[j] = Bs[kk][tx * 4 + j];
#pragma unroll
            for (int i = 0; i < 4; ++i)
#pragma unroll
                for (int j = 0; j < 4; ++j) acc[i][j] = fmaf(a[i], b[j], acc[i][j]);
        }
        __syncthreads();
    }
#pragma unroll
    for (int i = 0; i < 4; ++i)
#pragma unroll
        for (int j = 0; j < 4; ++j) {
            const int r = r0 + ty * 4 + i, c = c0 + tx * 4 + j;
            if (r < Mz) epi(z, r, c, acc[i][j]);
        }
}

__device__ __forceinline__ float sigmoidf_(float a) { return 1.f / (1.f + expf(-a)); }

struct EpiProj {
    bf16_t *upool, *q, *k, *v, *g, *xq, *gates;
    __device__ void operator()(int, int r, int c, float a) const {
        if (c < 512) upool[(size_t)r * 512 + c] = f2bf(a);
        else if (c < 1024) q[(size_t)r * 512 + c - 512] = f2bf(a);
        else if (c < 1536) k[(size_t)r * 512 + c - 1024] = f2bf(a);
        else if (c < 2560) v[(size_t)r * 1024 + c - 1536] = f2bf(a);
        else if (c < 3584) g[(size_t)r * 1024 + c - 2560] = f2bf(a * sigmoidf_(a));
        else if (c < 4096) xq[(size_t)r * 512 + c - 3584] = f2bf(a * 0.08838834764831845f);
        else gates[(size_t)r * 3072 + c - 4096] = f2bf(sigmoidf_(a));
    }
};
struct EpiMemKV {
    bf16_t *mk, *mv;
    __device__ void operator()(int, int r, int c, float a) const {
        if (c < 512) mk[(size_t)r * 512 + c] = f2bf(a); else mv[(size_t)r * 512 + c - 512] = f2bf(a);
    }
};
struct EpiPoolMap {
    bf16_t* ypool; const float* scale; int gofs;
    __device__ void operator()(int, int r, int c, float a) const { const int cc = gofs + c; ypool[(size_t)r * 512 + cc] = f2bf(a * scale[cc]); }
};
struct EpiGateAcc {
    float* out; const bf16_t* gates; int gofs; int first;
    __device__ void operator()(int, int r, int c, float a) const {
        const float gv = bf2f(gates[(size_t)r * 3072 + gofs + c]);
        float* p = out + (size_t)r * 1024 + c;
        *p = first ? gv * a : *p + gv * a;
    }
};
struct EpiResid {
    float* out; const float* x;
    __device__ void operator()(int, int r, int c, float a) const { out[(size_t)r * 1024 + c] = ALPHA * x[(size_t)r * 1024 + c] + a; }
};
struct EpiTmp {
    bf16_t* tmp; const int* base;
    __device__ void operator()(int z, int r, int c, float a) const { tmp[(size_t)(base[z] + r) * 256 + c] = f2bf(a); }
};
struct EpiAct {
    bf16_t* act; const bf16_t* tmp; const int* base;
    __device__ void operator()(int z, int r, int c, float b) const {
        const size_t o = (size_t)(base[z] + r) * 256 + c; const float a = bf2f(tmp[o]);
        act[o] = f2bf(a * sigmoidf_(a) * b);
    }
};
struct EpiY {
    bf16_t* y; const int* base;
    __device__ void operator()(int z, int r, int c, float a) const { y[(size_t)(base[z] + r) * 1024 + c] = f2bf(a); }
};

__device__ __forceinline__ float gamma_log(int h) { return log1pf(-exp2f(-5.0f - (float)h)); }

__global__ void k_rotary(bf16_t* q, bf16_t* k, const int* positions) {
    const int idx = blockIdx.x * blockDim.x + threadIdx.x;
    if (idx >= T * 256) return;
    const int i = idx & 63, h = (idx >> 6) & 3, t = idx >> 8;
    const double invf = pow(10000.0, -(double)i / 64.0);
    const double ang = (double)positions[t] * (double)(float)invf;
    const float cs = (float)cos(ang), sn = (float)sin(ang);
    const int c = t & (CH - 1);
    const float lg = gamma_log(h);
    const float qs = expf(lg * (float)c), ks = 0.08838834764831845f * expf(-lg * (float)c);
    const size_t o = (size_t)t * 512 + h * 128 + i;
    float x1 = bf2f(q[o]), x2 = bf2f(q[o + 64]);
    q[o] = f2bf((x1 * cs - x2 * sn) * qs); q[o + 64] = f2bf((x2 * cs + x1 * sn) * qs);
    x1 = bf2f(k[o]); x2 = bf2f(k[o + 64]);
    k[o] = f2bf((x1 * cs - x2 * sn) * ks); k[o + 64] = f2bf((x2 * cs + x1 * sn) * ks);
}

__global__ void k_pooled(const bf16_t* upool, bf16_t* pooled) {
    const int idx = blockIdx.x * blockDim.x + threadIdx.x;
    if (idx >= T * 512) return;
    const int c = idx & 511, t = idx >> 9, g = c >> 7, s = t & (SEQ - 1);
    const int w = 2 << g;
    const int n = (s + 1 < w) ? s + 1 : w;
    float sum = 0.f;
    for (int j = 0; j < n; ++j) sum += bf2f(upool[(size_t)(t - j) * 512 + c]);
    pooled[idx] = f2bf(sum / (float)n - bf2f(upool[idx]));
}

__global__ __launch_bounds__(256) void k_xattn(bf16_t* xq  , const bf16_t* mk, const bf16_t* mv) {
    __shared__ float qs[128]; __shared__ float ps[256]; __shared__ float red[8];
    const int t = blockIdx.x >> 2, h = blockIdx.x & 3, b = t / SEQ, tid = threadIdx.x;
    if (tid < 128) qs[tid] = bf2f(xq[(size_t)t * 512 + h * 128 + tid]);
    __syncthreads();
    const bf16_t* kr = mk + (size_t)(b * MEML + tid) * 512 + h * 128;
    float s = 0.f;
    for (int d = 0; d < 128; ++d) s += qs[d] * bf2f(kr[d]);
    float m = s;
    for (int o = 32; o > 0; o >>= 1) m = fmaxf(m, __shfl_xor(m, o));
    if ((tid & 63) == 0) red[tid >> 6] = m;
    __syncthreads();
    m = fmaxf(fmaxf(red[0], red[1]), fmaxf(red[2], red[3]));
    const float p = expf(s - m);
    float sum = p;
    for (int o = 32; o > 0; o >>= 1) sum += __shfl_xor(sum, o);
    if ((tid & 63) == 0) red[4 + (tid >> 6)] = sum;
    ps[tid] = p;
    __syncthreads();
    sum = red[4] + red[5] + red[6] + red[7];
    if (tid < 128) {
        float o = 0.f;
        for (int key = 0; key < 256; ++key) o += ps[key] * bf2f(mv[(size_t)(b * MEML + key) * 512 + h * 128 + tid]);
        xq[(size_t)t * 512 + h * 128 + tid] = f2bf(o / sum);
    }
}

__global__ __launch_bounds__(128) void k_ret_state(const bf16_t* k, const bf16_t* v, float* kvT) {
    const int u = blockIdx.x, h = u & 3, bn = u >> 2, e0 = blockIdx.y * 8, d = threadIdx.x;
    const size_t t0 = (size_t)bn * CH;
    float acc[8] = {};
    for (int s = 0; s < CH; ++s) {
        const float kd = bf2f(k[(t0 + s) * 512 + h * 128 + d]);
#pragma unroll
        for (int j = 0; j < 8; ++j) acc[j] += kd * bf2f(v[(t0 + s) * 1024 + h * 256 + e0 + j]);
    }
    const float sc = expf(gamma_log(h) * (float)(CH - 1));
#pragma unroll
    for (int j = 0; j < 8; ++j) kvT[((size_t)u * 256 + e0 + j) * 128 + d] = acc[j] * sc;
}
__global__ void k_scan(float* kvT) {
    const int idx = blockIdx.x * blockDim.x + threadIdx.x;
    if (idx >= BATCH * 4 * 32768) return;
    const int ed = idx & 32767, h = (idx >> 15) & 3, b = idx >> 17;
    const float cd = expf(gamma_log(h) * (float)CH);
    float st = 0.f;
    for (int n = 0; n < NCH; ++n) {
        float* p = kvT + ((size_t)((b * NCH + n) * 4 + h)) * 32768 + ed;
        const float inc = *p; *p = st; st = cd * st + inc;
    }
}
__global__ __launch_bounds__(256) void k_ret_out(const bf16_t* q, const bf16_t* k, const bf16_t* v, const float* prevT, bf16_t* g  , const float* gn_w) {
    __shared__ float qs[128]; __shared__ float sc[128]; __shared__ float red[8];
    const int u = blockIdx.x >> 7, c = blockIdx.x & 127, h = u & 3, bn = u >> 2, tid = threadIdx.x;
    const size_t t0 = (size_t)bn * CH, t = t0 + c;
    if (tid < 128) qs[tid] = bf2f(q[t * 512 + h * 128 + tid]);
    __syncthreads();
    if (tid < 128) {
        float s = 0.f;
        if (tid <= c) { const bf16_t* kr = k + (t0 + tid) * 512 + h * 128; for (int d = 0; d < 128; ++d) s += qs[d] * bf2f(kr[d]); }
        sc[tid] = s;
    }
    __syncthreads();
    const int e = tid;
    float y = 0.f;
    for (int s = 0; s <= c; ++s) y += sc[s] * bf2f(v[(t0 + s) * 1024 + h * 256 + e]);
    float cr = 0.f;
    const float* pr = prevT + ((size_t)u * 256 + e) * 128;
    for (int d = 0; d < 128; ++d) cr += qs[d] * pr[d];
    y += expf(gamma_log(h)) * cr;
    float sum = y;
    for (int o = 32; o > 0; o >>= 1) sum += __shfl_xor(sum, o);
    if ((tid & 63) == 0) red[tid >> 6] = sum;
    __syncthreads();
    const float mu = (red[0] + red[1] + red[2] + red[3]) * (1.f / 256.f);
    const float yc = y - mu;
    float sq = yc * yc;
    for (int o = 32; o > 0; o >>= 1) sq += __shfl_xor(sq, o);
    if ((tid & 63) == 0) red[4 + (tid >> 6)] = sq;
    __syncthreads();
    const float var = (red[4] + red[5] + red[6] + red[7]) * (1.f / 256.f);
    const float yn = yc * rsqrtf(var + LN_EPS) * gn_w[h * 256 + e];
    const size_t o = t * 1024 + h * 256 + e;
    g[o] = f2bf(bf2f(g[o]) * yn);
}

__global__ void k_f32_to_bf16(const float* in, bf16_t* out, size_t n) {
    const size_t i = (size_t)blockIdx.x * blockDim.x + threadIdx.x;
    if (i < n) out[i] = f2bf(in[i]);
}

struct TokInfo { int e0, e1, s0, s1; float w0, w1; int pad0, pad1; };
__device__ __forceinline__ float block_sum_256(float v, float* red) {
    for (int o = 32; o > 0; o >>= 1) v += __shfl_xor(v, o);
    __syncthreads();
    if ((threadIdx.x & 63) == 0) red[threadIdx.x >> 6] = v;
    __syncthreads();
    return red[0] + red[1] + red[2] + red[3];
}
__global__ __launch_bounds__(256) void k_ln1_router(float* hx, bf16_t* x1b, const float* ln_w, const float* ln_b,
                                                    const float* wgr, const float* bgr, const float* wer, const float* ber,
                                                    int* cnt, int* lists, TokInfo* info) {
    __shared__ float xs[1024]; __shared__ float red[4]; __shared__ float lg[36];
    const int t = blockIdx.x, tid = threadIdx.x;
    float v[4]; float s = 0.f;
#pragma unroll
    for (int j = 0; j < 4; ++j) { v[j] = hx[(size_t)t * 1024 + tid + 256 * j]; s += v[j]; }
    const float mu = block_sum_256(s, red) * (1.f / 1024.f);
    float sq = 0.f;
#pragma unroll
    for (int j = 0; j < 4; ++j) { v[j] -= mu; sq += v[j] * v[j]; }
    const float rstd = rsqrtf(block_sum_256(sq, red) * (1.f / 1024.f) + LN_EPS);
#pragma unroll
    for (int j = 0; j < 4; ++j) {
        const int c = tid + 256 * j; const float o = v[j] * rstd * ln_w[c] + ln_b[c];
        xs[c] = o; hx[(size_t)t * 1024 + c] = o; x1b[(size_t)t * 1024 + c] = f2bf(o);
    }
    __syncthreads();
    if (tid < 36) {
        float a = 0.f;
        if (tid < 4) { for (int kk = 0; kk < 1024; ++kk) a = fmaf(xs[kk], wgr[kk * 4 + tid], a); a += bgr[tid]; }
        else { const int j = tid - 4; for (int kk = 0; kk < 1024; ++kk) a = fmaf(xs[kk], wer[kk * 32 + j], a); a += ber[j]; }
        lg[tid] = a;
    }
    __syncthreads();
    if (tid == 0) {
        float m = lg[0]; int gs = 0;
        for (int j = 1; j < 4; ++j) if (lg[j] > m) { m = lg[j]; gs = j; }
        float den = 0.f;
        for (int j = 0; j < 4; ++j) den += expf(lg[j] - m);
        const float pg = 1.f / den;
        const float* el = lg + 4 + gs * 8;
        int i0 = 0; float v0 = el[0];
        for (int j = 1; j < 8; ++j) if (el[j] > v0) { v0 = el[j]; i0 = j; }
        int i1 = -1; float v1 = 0.f;
        for (int j = 0; j < 8; ++j) if (j != i0 && (i1 < 0 || el[j] > v1)) { v1 = el[j]; i1 = j; }
        const float e1 = expf(v1 - v0);
        const float w0 = pg / (1.f + e1), w1 = pg * e1 / (1.f + e1);
        TokInfo ti; ti.e0 = gs * 8 + i0; ti.e1 = gs * 8 + i1; ti.w0 = w0; ti.w1 = w1; ti.pad0 = 0; ti.pad1 = 0;
        ti.s0 = atomicAdd(&cnt[ti.e0], 1); ti.s1 = atomicAdd(&cnt[ti.e1], 1);
        lists[ti.e0 * T + ti.s0] = t; lists[ti.e1 * T + ti.s1] = t;
        info[t] = ti;
    }
}
__global__ void k_moe_plan(const int* cnt, int* base) {
    if (threadIdx.x == 0 && blockIdx.x == 0) { int b = 0; for (int e = 0; e < NEXP; ++e) { base[e] = b; b += (cnt[e] + 255) & ~255; } base[NEXP] = b; }
}
__global__ __launch_bounds__(256) void k_final(float* x1, const bf16_t* y, const TokInfo* info, const int* base, const float* ln_w, const float* ln_b) {
    __shared__ float red[4];
    const int t = blockIdx.x, tid = threadIdx.x;
    const TokInfo ti = info[t];
    const size_t r0 = (size_t)(base[ti.e0] + ti.s0) * 1024, r1 = (size_t)(base[ti.e1] + ti.s1) * 1024;
    float v[4]; float s = 0.f;
#pragma unroll
    for (int j = 0; j < 4; ++j) { const int c = tid + 256 * j; v[j] = ALPHA * x1[(size_t)t * 1024 + c] + ti.w0 * bf2f(y[r0 + c]) + ti.w1 * bf2f(y[r1 + c]); s += v[j]; }
    const float mu = block_sum_256(s, red) * (1.f / 1024.f);
    float sq = 0.f;
#pragma unroll
    for (int j = 0; j < 4; ++j) { v[j] -= mu; sq += v[j] * v[j]; }
    const float rstd = rsqrtf(block_sum_256(sq, red) * (1.f / 1024.f) + LN_EPS);
#pragma unroll
    for (int j = 0; j < 4; ++j) { const int c = tid + 256 * j; x1[(size_t)t * 1024 + c] = v[j] * rstd * ln_w[c] + ln_b[c]; }
}

template <typename TA, typename Epi>
static void launch_gemm(hipStream_t st, const TA* A, int lda, const int* rowidx, int ridx_zs, const int* Mptr, int M, const int* arow0,
                        const float* B, int ldb, size_t b_zs, int N, int K, int Z, Epi epi) {
    dim3 grid(N / 64, (M + 63) / 64, Z);
    hipLaunchKernelGGL((gemm_naive<TA, Epi>), grid, dim3(256), 0, st, A, lda, rowidx, ridx_zs, Mptr, M, arow0, B, ldb, b_zs, N, K, epi);
}

extern "C" void kernel_launch(void* const* d_in, const int* in_sizes, int n_in, void* d_out, int out_size, void* d_ws, size_t ws_size, hipStream_t stream) {
    const float* x = (const float*)d_in[0]; const float* mem = (const float*)d_in[1]; const int* positions = (const int*)d_in[2];
    const float* w_in = (const float*)d_in[3]; const float* w_pool_grp = (const float*)d_in[4]; const float* pool_scale = (const float*)d_in[5];
    const float* ret_gn_w = (const float*)d_in[6]; const float* w_mem_kv = (const float*)d_in[7]; const float* w_br_pool = (const float*)d_in[8];
    const float* w_br_ret = (const float*)d_in[9]; const float* w_br_xa = (const float*)d_in[10]; const float* w_out = (const float*)d_in[11];
    const float* ln1_w = (const float*)d_in[12]; const float* ln1_b = (const float*)d_in[13];
    const float* wgr = (const float*)d_in[14]; const float* bgr = (const float*)d_in[15]; const float* wer = (const float*)d_in[16]; const float* ber = (const float*)d_in[17];
    const float* w_eg = (const float*)d_in[18]; const float* w_eu = (const float*)d_in[19]; const float* w_ed = (const float*)d_in[20];
    const float* ln2_w = (const float*)d_in[21]; const float* ln2_b = (const float*)d_in[22];
    unsigned char* ws = (unsigned char*)d_ws; float* out = (float*)d_out;
    int* ctl = (int*)(ws + WS_CTL); int* cnt = ctl + CW_CNT; int* base = ctl + CW_BASE;
    TokInfo* info = (TokInfo*)(ws + WS_TOKINFO); int* lists = (int*)(ws + WS_LISTS);
    bf16_t *upool = (bf16_t*)(ws + WS_UPOOL), *q = (bf16_t*)(ws + WS_Q), *k = (bf16_t*)(ws + WS_K), *v = (bf16_t*)(ws + WS_V), *g = (bf16_t*)(ws + WS_G),
           *xq = (bf16_t*)(ws + WS_XQ), *gates = (bf16_t*)(ws + WS_GATES), *mk = (bf16_t*)(ws + WS_MEMK), *mv = (bf16_t*)(ws + WS_MEMV),
           *pooled = (bf16_t*)(ws + WS_POOLED), *merged = (bf16_t*)(ws + WS_MERGED), *x1b = (bf16_t*)(ws + WS_X1B), *act = (bf16_t*)(ws + WS_ACT),
           *tmp = (bf16_t*)(ws + WS_TMP), *y = (bf16_t*)(ws + WS_Y);
    hipMemsetAsync(ws + WS_CTL, 0, 1 * MiB, stream);
    launch_gemm<float>(stream, x, 1024, nullptr, 0, nullptr, T, nullptr, w_in, NIN, 0, NIN, 1024, 1, EpiProj{upool, q, k, v, g, xq, gates});
    launch_gemm<float>(stream, mem, 1024, nullptr, 0, nullptr, BATCH * MEML, nullptr, w_mem_kv, 1024, 0, 1024, 1024, 1, EpiMemKV{mk, mv});
    hipLaunchKernelGGL(k_rotary, dim3(T * 256 / 256), dim3(256), 0, stream, q, k, positions);
    hipLaunchKernelGGL(k_pooled, dim3(T * 512 / 256), dim3(256), 0, stream, upool, pooled);
    hipLaunchKernelGGL(k_xattn, dim3(T * 4), dim3(256), 0, stream, xq, mk, mv);
    hipLaunchKernelGGL(k_ret_state, dim3(512, 32), dim3(128), 0, stream, k, v, out);
    hipLaunchKernelGGL(k_scan, dim3(BATCH * 4 * 32768 / 256), dim3(256), 0, stream, out);
    for (int gi = 0; gi < 4; ++gi)
        launch_gemm<bf16_t>(stream, pooled + gi * 128, 512, nullptr, 0, nullptr, T, nullptr, w_pool_grp + (size_t)gi * 128 * 128, 128, 0, 128, 128, 1,
                            EpiPoolMap{upool, pool_scale, gi * 128});
    hipLaunchKernelGGL(k_ret_out, dim3(512 * 128), dim3(256), 0, stream, q, k, v, out, g, ret_gn_w);
    launch_gemm<bf16_t>(stream, upool, 512, nullptr, 0, nullptr, T, nullptr, w_br_pool, 1024, 0, 1024, 512, 1, EpiGateAcc{out, gates, 0, 1});
    launch_gemm<bf16_t>(stream, g, 1024, nullptr, 0, nullptr, T, nullptr, w_br_ret, 1024, 0, 1024, 1024, 1, EpiGateAcc{out, gates, 1024, 0});
    launch_gemm<bf16_t>(stream, xq, 512, nullptr, 0, nullptr, T, nullptr, w_br_xa, 1024, 0, 1024, 512, 1, EpiGateAcc{out, gates, 2048, 0});
    hipLaunchKernelGGL(k_f32_to_bf16, dim3(T * 1024 / 256), dim3(256), 0, stream, out, merged, (size_t)T * 1024);
    launch_gemm<bf16_t>(stream, merged, 1024, nullptr, 0, nullptr, T, nullptr, w_out, 1024, 0, 1024, 1024, 1, EpiResid{out, x});
    hipLaunchKernelGGL(k_ln1_router, dim3(T), dim3(256), 0, stream, out, x1b, ln1_w, ln1_b, wgr, bgr, wer, ber, cnt, lists, info);
    hipLaunchKernelGGL(k_moe_plan, dim3(1), dim3(64), 0, stream, cnt, base);
    launch_gemm<bf16_t>(stream, x1b, 1024, lists, T, cnt, T, nullptr, w_eg, 256, (size_t)1024 * 256, 256, 1024, NEXP, EpiTmp{tmp, base});
    launch_gemm<bf16_t>(stream, x1b, 1024, lists, T, cnt, T, nullptr, w_eu, 256, (size_t)1024 * 256, 256, 1024, NEXP, EpiAct{act, tmp, base});
    launch_gemm<bf16_t>(stream, act, 256, nullptr, 0, cnt, T, base, w_ed, 1024, (size_t)256 * 1024, 1024, 256, NEXP, EpiY{y, base});
    hipLaunchKernelGGL(k_final, dim3(T), dim3(256), 0, stream, out, y, info, base, ln2_w, ln2_b);
}
```

```cpp
#include <hip/hip_runtime.h>
#include <stdint.h>
#include <math.h>
#include <cstdio>

typedef unsigned short bf16_t;
__device__ __forceinline__ float bf2f(bf16_t h) { return __uint_as_float(((unsigned)h) << 16); }
__device__ __forceinline__ bf16_t f2bf(float f) { unsigned u = __float_as_uint(f); return (bf16_t)((u + 0x7fffu + ((u >> 16) & 1u)) >> 16); }

constexpr int D = 1024, BATCH = 4, SEQ = 4096, T = BATCH * SEQ, MEML = 256;
constexpr int NIN = 7168;
constexpr int CH = 128, NCH = SEQ / CH;
constexpr int NEXP = 32, DEXP = 256;
constexpr float LN_EPS = 1e-5f;
constexpr float ALPHA = 1.189207115002721f;
constexpr size_t MiB = 1u << 20;
constexpr size_t WS_CTL = 0, WS_TOKINFO = 1 * MiB, WS_LISTS = 2 * MiB;
constexpr size_t WS_WPT = 4 * MiB, WS_WRT = 5 * MiB, WS_WXT = 7 * MiB, WS_WOUTT = 8 * MiB, WS_WPOOLBD = 10 * MiB;
constexpr size_t WS_MEMK = 11 * MiB, WS_MEMV = 12 * MiB, WS_POOLED = 13 * MiB;
constexpr size_t WS_UPOOL = 32 * MiB, WS_Q = 48 * MiB, WS_K = 64 * MiB, WS_V = 80 * MiB, WS_G = 112 * MiB, WS_XQ = 144 * MiB, WS_GATES = 160 * MiB;
constexpr size_t WS_MERGED = 48 * MiB, WS_X1B = 80 * MiB, WS_ACT = 32 * MiB, WS_TMP = 52 * MiB, WS_Y = 176 * MiB;
constexpr size_t WS_MOEW1 = 112 * MiB, WS_MOEW2 = 144 * MiB;
constexpr size_t DO_XB = 0, DO_WINT = 32 * MiB, DO_MEMB = 46 * MiB, DO_WMEMT = 48 * MiB, DO_CS = 50 * MiB;
constexpr int CW_CNT = 1024;
constexpr int CW_BASE = 1088;
constexpr int CW_BAR = 4096;

namespace pg8 {
#define PG8_LAS __attribute__((address_space(3)))
typedef unsigned short bf16_t;
typedef short bf16x8 __attribute__((ext_vector_type(8)));
typedef float f32x4 __attribute__((ext_vector_type(4)));
typedef unsigned u32x4 __attribute__((ext_vector_type(4)));
constexpr int BM = 256, BK = 64, HALF = 128, HTB = HALF * BK * 2  , STAGE_BYTES = 8 * HTB, NXCD = 8, WGM = 8;

__host__ __device__ __forceinline__ int lds_byte(int r, int c) { const int st = (r >> 4) * 2 + (c >> 5), rr = r & 15, cc = c & 31, ob = rr * 64 + cc * 2; return st * 1024 + (ob ^ (((ob >> 9) & 1) << 5)); }
__host__ __device__ __forceinline__ void stage_rc(int b, int& R, int& C) { const int st = b / 1024, sb = b % 1024, swz = sb ^ (((sb >> 9) & 1) << 5); R = (st >> 1) * 16 + swz / 64; C = (st & 1) * 32 + (swz % 64) / 2; }
__host__ __device__ __forceinline__ int perm32(int rho) { const int n = rho >> 4, i = rho & 15; return 8 * (i >> 2) + 4 * n + (i & 3); }

struct Unit { int pm, pn; };
struct Gemm { const bf16_t* A; const bf16_t* Bt; int M, N, K; };

struct StaticOrder {
    int nM, nN, nwg, G, c;
    __host__ __device__ void init(int M, int N, int G_, int c_) { nM = M / BM; nN = N / BM; nwg = nM * nN; G = G_; c = c_; }
    __host__ __device__ bool next(int i, Unit& u) const {
        const long L = (long)i * G + c; if (L >= nwg) return false;
        int wgid = (int)L; { const int q = nwg / NXCD, r = nwg % NXCD, xcd = wgid % NXCD, off = wgid / NXCD; wgid = (xcd < r ? xcd * (q + 1) : r * (q + 1) + (xcd - r) * q) + off; }
        const int nig = WGM * nN, gid = wgid / nig, fm = gid * WGM, gsz = (nM - fm) < WGM ? (nM - fm) : WGM;
        u.pm = fm + ((wgid % nig) % gsz); u.pn = (wgid % nig) / gsz; return true;
    }
    __device__ __forceinline__ void a_ready(const Unit&) const {}
    __device__ __forceinline__ void done(const Unit&) const {}
};


template <class Epi, class Sched, bool ALIGN_EPI = false, bool SP2 = false>
__device__ __forceinline__ void gemm_phase(PG8_LAS unsigned char* lds, const Gemm g, const Sched& S, const Epi& E) {
    const int tid = threadIdx.x, wid = __builtin_amdgcn_readfirstlane(tid >> 6), lane = tid & 63, wr = wid >> 2, wc = wid & 3, fr = lane & 15, fq = lane >> 4;
    const int K = g.K, nt = K / BK;
    unsigned voffA[2], voffB[2];
#pragma unroll
    for (int i = 0; i < 2; ++i) { int R, C; stage_rc(tid * 16 + i * 8192, R, C); const int Rb = Epi::PERM ? ((R & ~31) + perm32(R & 31)) : R;
        voffA[i] = (unsigned)(R * K + C) * 2u; voffB[i] = (unsigned)(Rb * K + C) * 2u; }
    const size_t kstep = (size_t)(BK * 2);
    const size_t hstep = (size_t)HALF * K * 2;
    const size_t tstep = 2 * hstep;
    const unsigned ldsw = (unsigned)wid * 1024u;
    const int aoff = lds_byte(wr * 64 + fr, fq * 8), boff = lds_byte(wc * 32 + fr, fq * 8);
#define PG8_SA(b, h) (((b) * 2 + (h)) * HTB)
#define PG8_SB(b, h) ((4 + (b) * 2 + (h)) * HTB)
#define PG8_STAGE(bufoff, gbase, voff) do { _Pragma("unroll") for (int _i = 0; _i < 2; ++_i) \
        __builtin_amdgcn_global_load_lds((const unsigned*)((const char*)(gbase) + (voff)[_i]), (PG8_LAS unsigned*)(lds + (bufoff) + ldsw + _i * 8192), 16, 0, 0); } while (0)
#define PG8_LDA(dst, b, h) do { _Pragma("unroll") for (int m = 0; m < 4; ++m) _Pragma("unroll") for (int k = 0; k < 2; ++k) dst[m][k] = *(const PG8_LAS bf16x8*)(lds + PG8_SA(b, h) + aoff + m * 2048 + k * 1024); } while (0)
#define PG8_LDB(dst, b, h) do { _Pragma("unroll") for (int n = 0; n < 2; ++n) _Pragma("unroll") for (int k = 0; k < 2; ++k) dst[n][k] = *(const PG8_LAS bf16x8*)(lds + PG8_SB(b, h) + boff + n * 2048 + k * 1024); } while (0)
#define PG8_MMA(ai, bj, At, Bt) do { __builtin_amdgcn_s_setprio(1); _Pragma("unroll") for (int m = 0; m < 4; ++m) _Pragma("unroll") for (int n = 0; n < 2; ++n) _Pragma("unroll") for (int k = 0; k < 2; ++k) \
        acc[ai][bj][m][n] = __builtin_amdgcn_mfma_f32_16x16x32_bf16(Bt[n][k], At[m][k], acc[ai][bj][m][n], 0, 0, 0); __builtin_amdgcn_s_setprio(0); } while (0)
#define PG8_WAIT_V(n) asm volatile("s_waitcnt vmcnt(" #n ")" ::: "memory")
#define PG8_WAIT_L(n) asm volatile("s_waitcnt lgkmcnt(" #n ")" ::: "memory")
#define PG8_BAR __builtin_amdgcn_s_barrier()
#define PG8_SCHED __builtin_amdgcn_sched_barrier(0)
    Unit cur, nxt; int ui = 0;
    if (!S.next(0, cur)) return;
    f32x4 acc[2][2][4][2];
#pragma unroll
    for (int a = 0; a < 2; ++a)
#pragma unroll
        for (int b = 0; b < 2; ++b)
#pragma unroll
            for (int m = 0; m < 4; ++m)
#pragma unroll
                for (int n = 0; n < 2; ++n) acc[a][b][m][n] = (f32x4){0.f, 0.f, 0.f, 0.f};
    bf16x8 At[4][2], B0[2][2], B1[2][2];
    const char* cA = (const char*)g.A + (size_t)cur.pm * tstep; const char* cB = (const char*)g.Bt + (size_t)cur.pn * tstep;
    S.a_ready(cur);
    if constexpr (SP2) {
        PG8_STAGE(PG8_SB(0, 0), cB, voffB); PG8_STAGE(PG8_SB(0, 1), cB + hstep, voffB); PG8_STAGE(PG8_SA(0, 0), cA, voffA); PG8_STAGE(PG8_SA(0, 1), cA + hstep, voffA);
        if (wr == 1) PG8_BAR;
        PG8_WAIT_V(2); PG8_BAR;
        PG8_STAGE(PG8_SB(1, 0), cB + kstep, voffB); PG8_STAGE(PG8_SA(1, 0), cA + kstep, voffA); PG8_STAGE(PG8_SB(1, 1), cB + hstep + kstep, voffB);
        PG8_WAIT_V(6); PG8_BAR;
    } else {
        PG8_STAGE(PG8_SB(0, 0), cB, voffB); PG8_STAGE(PG8_SA(0, 0), cA, voffA); PG8_STAGE(PG8_SB(0, 1), cB + hstep, voffB); PG8_STAGE(PG8_SA(0, 1), cA + hstep, voffA);
        if (wr == 1) PG8_BAR;
        PG8_WAIT_V(4); PG8_BAR;
        PG8_STAGE(PG8_SB(1, 0), cB + kstep, voffB); PG8_STAGE(PG8_SA(1, 0), cA + kstep, voffA); PG8_STAGE(PG8_SB(1, 1), cB + hstep + kstep, voffB);
        PG8_WAIT_V(6); PG8_BAR;
    }
    for (;;) {
        const bool has_next = S.next(ui + 1, nxt);
        const char* nA = has_next ? (const char*)g.A + (size_t)nxt.pm * tstep : cA; const char* nB = has_next ? (const char*)g.Bt + (size_t)nxt.pn * tstep : cB;
#pragma unroll 1
        for (int t = 0; t < nt; t += 2) {
            const bool last = (t == nt - 2);
            const char* a1 = cA + (size_t)(t + 1) * kstep;
            const char* a2 = last ? nA : cA + (size_t)(t + 2) * kstep; const char* b2 = last ? nB : cB + (size_t)(t + 2) * kstep;
            const char* a3 = a2 + kstep; const char* b3 = b2 + kstep;
            if (last && has_next) S.a_ready(nxt);
            if constexpr (SP2) {
            PG8_LDB(B0, 0, 0); PG8_LDB(B1, 0, 1); PG8_SCHED; PG8_LDA(At, 0, 0); PG8_STAGE(PG8_SA(1, 1), a1 + hstep, voffA);
            PG8_WAIT_V(8); PG8_WAIT_L(0); PG8_BAR; PG8_MMA(0, 0, At, B0); PG8_MMA(0, 1, At, B1); PG8_BAR; PG8_SCHED;
            PG8_LDA(At, 0, 1); PG8_STAGE(PG8_SB(0, 0), b2, voffB); PG8_STAGE(PG8_SB(0, 1), b2 + hstep, voffB); PG8_STAGE(PG8_SA(0, 0), a2, voffA);
            PG8_WAIT_V(8); PG8_WAIT_L(0); PG8_BAR; PG8_MMA(1, 0, At, B0); PG8_MMA(1, 1, At, B1); PG8_BAR; PG8_SCHED;
            PG8_LDB(B0, 1, 0); PG8_LDB(B1, 1, 1); PG8_SCHED; PG8_LDA(At, 1, 0); PG8_STAGE(PG8_SA(0, 1), a2 + hstep, voffA);
            PG8_WAIT_V(8); PG8_WAIT_L(0); PG8_BAR; PG8_MMA(0, 0, At, B0); PG8_MMA(0, 1, At, B1); PG8_BAR; PG8_SCHED;
            PG8_LDA(At, 1, 1); PG8_STAGE(PG8_SB(1, 0), b3, voffB); PG8_STAGE(PG8_SB(1, 1), b3 + hstep, voffB); PG8_STAGE(PG8_SA(1, 0), a3, voffA);
            PG8_WAIT_V(8); PG8_WAIT_L(0); PG8_BAR; PG8_MMA(1, 0, At, B0); PG8_MMA(1, 1, At, B1); PG8_BAR; PG8_SCHED;
            } else {
            PG8_LDB(B0, 0, 0); PG8_SCHED; PG8_LDA(At, 0, 0); PG8_STAGE(PG8_SA(1, 1), a1 + hstep, voffA);
            PG8_WAIT_L(8); PG8_BAR; PG8_WAIT_L(0); PG8_MMA(0, 0, At, B0); PG8_BAR; PG8_SCHED;
            PG8_LDB(B1, 0, 1); PG8_STAGE(PG8_SB(0, 0), b2, voffB);
            PG8_BAR; PG8_WAIT_L(0); PG8_MMA(0, 1, At, B1); PG8_BAR;
            PG8_LDA(At, 0, 1); PG8_STAGE(PG8_SA(0, 0), a2, voffA);
            PG8_BAR; PG8_WAIT_L(0); PG8_MMA(1, 0, At, B0); PG8_BAR; PG8_SCHED;
            PG8_STAGE(PG8_SB(0, 1), b2 + hstep, voffB);
            PG8_WAIT_V(6); PG8_BAR; PG8_MMA(1, 1, At, B1); PG8_BAR;
            PG8_LDB(B0, 1, 0); PG8_SCHED; PG8_LDA(At, 1, 0); PG8_STAGE(PG8_SA(0, 1), a2 + hstep, voffA);
            PG8_WAIT_L(8); PG8_BAR; PG8_WAIT_L(0); PG8_MMA(0, 0, At, B0); PG8_BAR; PG8_SCHED;
            PG8_LDB(B1, 1, 1); PG8_STAGE(PG8_SB(1, 0), b3, voffB);
            PG8_BAR; PG8_WAIT_L(0); PG8_MMA(0, 1, At, B1); PG8_BAR;
            PG8_LDA(At, 1, 1); PG8_STAGE(PG8_SA(1, 0), a3, voffA);
            PG8_BAR; PG8_WAIT_L(0); PG8_MMA(1, 0, At, B0); PG8_BAR; PG8_SCHED;
            PG8_STAGE(PG8_SB(1, 1), b3 + hstep, voffB);
            PG8_WAIT_V(6); PG8_BAR; PG8_MMA(1, 1, At, B1); PG8_BAR;
            }
        }
        if constexpr (ALIGN_EPI) { if (wr == 0) PG8_BAR; }
        if constexpr (!Epi::AFTER_DRAIN) { E(acc, cur, wr, wc, fr, fq); S.done(cur); }
        if (!has_next) break;
#pragma unroll
        for (int a = 0; a < 2; ++a)
#pragma unroll
            for (int b = 0; b < 2; ++b)
#pragma unroll
                for (int m = 0; m < 4; ++m)
#pragma unroll
                    for (int n = 0; n < 2; ++n) acc[a][b][m][n] = (f32x4){0.f, 0.f, 0.f, 0.f};
        cur = nxt; cA = nA; cB = nB; ++ui;
        if constexpr (ALIGN_EPI) { if (wr == 1) PG8_BAR; }
    }
    PG8_WAIT_V(0);
    if constexpr (!ALIGN_EPI) { if (wr == 0) PG8_BAR; }
    PG8_BAR;
    if constexpr (Epi::AFTER_DRAIN) { E.fused(acc, cur, wr, wc, fr, fq, lds, wid, lane); S.done(cur); }
#undef PG8_SA
#undef PG8_SB
#undef PG8_STAGE
#undef PG8_LDA
#undef PG8_LDB
#undef PG8_MMA
#undef PG8_WAIT_V
#undef PG8_WAIT_L
#undef PG8_BAR
#undef PG8_SCHED
}
}

namespace pg8 {
struct UnitG : Unit { int e; };
template <class Epi, class Sched>
__device__ __forceinline__ void gemm_phase_g(PG8_LAS unsigned char* lds, const int K, const Sched& S, const Epi& E) {
    const int tid = threadIdx.x, wid = __builtin_amdgcn_readfirstlane(tid >> 6), lane = tid & 63, wr = wid >> 2, wc = wid & 3, fr = lane & 15, fq = lane >> 4;
    const int nt = K / BK;
    unsigned voffB[2];
#pragma unroll
    for (int i = 0; i < 2; ++i) { int R, C; stage_rc(tid * 16 + i * 8192, R, C); const int Rb = Epi::PERM ? ((R & ~31) + perm32(R & 31)) : R;
        voffB[i] = (unsigned)(Rb * K + C) * 2u; }
    const size_t kstep = (size_t)(BK * 2);
    const size_t hstep = (size_t)HALF * K * 2;
    const unsigned ldsw = (unsigned)wid * 1024u;
    const int aoff = lds_byte(wr * 64 + fr, fq * 8), boff = lds_byte(wc * 32 + fr, fq * 8);
#define PG8_SA(b, h) (((b) * 2 + (h)) * HTB)
#define PG8_SB(b, h) ((4 + (b) * 2 + (h)) * HTB)
#define PG8_STAGE(bufoff, gbase, voff) do { _Pragma("unroll") for (int _i = 0; _i < 2; ++_i) \
        __builtin_amdgcn_global_load_lds((const unsigned*)((const char*)(gbase) + (voff)[_i]), (PG8_LAS unsigned*)(lds + (bufoff) + ldsw + _i * 8192), 16, 0, 0); } while (0)
#define PG8_LDA(dst, b, h) do { _Pragma("unroll") for (int m = 0; m < 4; ++m) _Pragma("unroll") for (int k = 0; k < 2; ++k) dst[m][k] = *(const PG8_LAS bf16x8*)(lds + PG8_SA(b, h) + aoff + m * 2048 + k * 1024); } while (0)
#define PG8_LDB(dst, b, h) do { _Pragma("unroll") for (int n = 0; n < 2; ++n) _Pragma("unroll") for (int k = 0; k < 2; ++k) dst[n][k] = *(const PG8_LAS bf16x8*)(lds + PG8_SB(b, h) + boff + n * 2048 + k * 1024); } while (0)
#define PG8_MMA(ai, bj, At, Bt) do { __builtin_amdgcn_s_setprio(1); _Pragma("unroll") for (int m = 0; m < 4; ++m) _Pragma("unroll") for (int n = 0; n < 2; ++n) _Pragma("unroll") for (int k = 0; k < 2; ++k) \
        acc[ai][bj][m][n] = __builtin_amdgcn_mfma_f32_16x16x32_bf16(Bt[n][k], At[m][k], acc[ai][bj][m][n], 0, 0, 0); __builtin_amdgcn_s_setprio(0); } while (0)
#define PG8_WAIT_V(n) asm volatile("s_waitcnt vmcnt(" #n ")" ::: "memory")
#define PG8_WAIT_L(n) asm volatile("s_waitcnt lgkmcnt(" #n ")" ::: "memory")
#define PG8_BAR __builtin_amdgcn_s_barrier()
#define PG8_SCHED __builtin_amdgcn_sched_barrier(0)
    UnitG cur, nxt; int ui = 0;
    if (!S.next(0, cur)) return;
    f32x4 acc[2][2][4][2];
#pragma unroll
    for (int a = 0; a < 2; ++a)
#pragma unroll
        for (int b = 0; b < 2; ++b)
#pragma unroll
            for (int m = 0; m < 4; ++m)
#pragma unroll
                for (int n = 0; n < 2; ++n) acc[a][b][m][n] = (f32x4){0.f, 0.f, 0.f, 0.f};
    bf16x8 At[4][2], B0[2][2], B1[2][2];
    const char* cA = S.a_base(cur); const char* cB = S.b_base(cur);
    unsigned vA0[2], vA1[2];
#pragma unroll
    for (int i = 0; i < 2; ++i) { int R, C; stage_rc(tid * 16 + i * 8192, R, C); vA0[i] = S.a_voff(cur, R, C, 0); vA1[i] = S.a_voff(cur, R, C, 1); }
    PG8_STAGE(PG8_SB(0, 0), cB, voffB); PG8_STAGE(PG8_SB(0, 1), cB + hstep, voffB); PG8_STAGE(PG8_SA(0, 0), cA, vA0); PG8_STAGE(PG8_SA(0, 1), cA, vA1);
    if (wr == 1) PG8_BAR;
    PG8_WAIT_V(2); PG8_BAR;
    PG8_STAGE(PG8_SB(1, 0), cB + kstep, voffB); PG8_STAGE(PG8_SA(1, 0), cA + kstep, vA0); PG8_STAGE(PG8_SB(1, 1), cB + hstep + kstep, voffB);
    PG8_WAIT_V(6); PG8_BAR;
    for (;;) {
        const bool has_next = S.next(ui + 1, nxt);
        const char* nA = has_next ? S.a_base(nxt) : cA; const char* nB = has_next ? S.b_base(nxt) : cB;
#pragma unroll 1
        for (int t = 0; t < nt; t += 2) {
            const bool last = (t == nt - 2);
            const char* a1 = cA + (size_t)(t + 1) * kstep;
            const char* a2 = last ? nA : cA + (size_t)(t + 2) * kstep; const char* b2 = last ? nB : cB + (size_t)(t + 2) * kstep;
            const char* a3 = a2 + kstep; const char* b3 = b2 + kstep;
            unsigned sA0[2], sA1[2];
#pragma unroll
            for (int i = 0; i < 2; ++i) { sA0[i] = vA0[i]; sA1[i] = vA1[i]; }
            if (last && has_next) {
#pragma unroll
                for (int i = 0; i < 2; ++i) { int R, C; stage_rc(tid * 16 + i * 8192, R, C); sA0[i] = S.a_voff(nxt, R, C, 0); sA1[i] = S.a_voff(nxt, R, C, 1); }
            }
            PG8_LDB(B0, 0, 0); PG8_LDB(B1, 0, 1); PG8_SCHED; PG8_LDA(At, 0, 0); PG8_STAGE(PG8_SA(1, 1), a1, vA1);
            PG8_WAIT_V(8); PG8_WAIT_L(0); PG8_BAR; PG8_MMA(0, 0, At, B0); PG8_MMA(0, 1, At, B1); PG8_BAR; PG8_SCHED;
            PG8_LDA(At, 0, 1); PG8_STAGE(PG8_SB(0, 0), b2, voffB); PG8_STAGE(PG8_SB(0, 1), b2 + hstep, voffB); PG8_STAGE(PG8_SA(0, 0), a2, sA0);
            PG8_WAIT_V(8); PG8_WAIT_L(0); PG8_BAR; PG8_MMA(1, 0, At, B0); PG8_MMA(1, 1, At, B1); PG8_BAR; PG8_SCHED;
            PG8_LDB(B0, 1, 0); PG8_LDB(B1, 1, 1); PG8_SCHED; PG8_LDA(At, 1, 0); PG8_STAGE(PG8_SA(0, 1), a2, sA1);
            PG8_WAIT_V(8); PG8_WAIT_L(0); PG8_BAR; PG8_MMA(0, 0, At, B0); PG8_MMA(0, 1, At, B1); PG8_BAR; PG8_SCHED;
            PG8_LDA(At, 1, 1); PG8_STAGE(PG8_SB(1, 0), b3, voffB); PG8_STAGE(PG8_SB(1, 1), b3 + hstep, voffB); PG8_STAGE(PG8_SA(1, 0), a3, sA0);
            PG8_WAIT_V(8); PG8_WAIT_L(0); PG8_BAR; PG8_MMA(1, 0, At, B0); PG8_MMA(1, 1, At, B1); PG8_BAR; PG8_SCHED;
        }
        if (wr == 0) PG8_BAR;
        E(acc, cur, wr, wc, fr, fq);
        if (!has_next) break;
#pragma unroll
        for (int a = 0; a < 2; ++a)
#pragma unroll
            for (int b = 0; b < 2; ++b)
#pragma unroll
                for (int m = 0; m < 4; ++m)
#pragma unroll
                    for (int n = 0; n < 2; ++n) acc[a][b][m][n] = (f32x4){0.f, 0.f, 0.f, 0.f};
        cur = nxt; cA = nA; cB = nB; ++ui;
#pragma unroll
        for (int i = 0; i < 2; ++i) { int R, C; stage_rc(tid * 16 + i * 8192, R, C); vA0[i] = S.a_voff(cur, R, C, 0); vA1[i] = S.a_voff(cur, R, C, 1); }
        if (wr == 1) PG8_BAR;
    }
    PG8_WAIT_V(0);
    PG8_BAR;
#undef PG8_SA
#undef PG8_SB
#undef PG8_STAGE
#undef PG8_LDA
#undef PG8_LDB
#undef PG8_MMA
#undef PG8_WAIT_V
#undef PG8_WAIT_L
#undef PG8_BAR
#undef PG8_SCHED
}
}

namespace pg8 {
typedef unsigned u32x2 __attribute__((ext_vector_type(2)));
typedef __bf16 bf16x2_t __attribute__((ext_vector_type(2)));
typedef float f32x2_t __attribute__((ext_vector_type(2)));
__device__ __forceinline__ unsigned cvt_pk_bf16(float lo, float hi) { f32x2_t v = {lo, hi}; bf16x2_t r = __builtin_convertvector(v, bf16x2_t); return __builtin_bit_cast(unsigned, r); }
__device__ __forceinline__ float fast_sigmoid(float x) { return __builtin_amdgcn_rcpf(1.f + __builtin_amdgcn_exp2f(-1.4426950408889634f * x)); }
__device__ __forceinline__ void store8(bf16_t* p, const f32x4& v0, const f32x4& v1) {
    u32x4 w; w.x = cvt_pk_bf16(v0[0], v0[1]); w.y = cvt_pk_bf16(v0[2], v0[3]); w.z = cvt_pk_bf16(v1[0], v1[1]); w.w = cvt_pk_bf16(v1[2], v1[3]); *(u32x4*)p = w;
}
__device__ __forceinline__ float log2_gamma(int h) { return h == 0 ? -0.045803689613124944f : (h == 1 ? -0.022720076500083580f : (h == 2 ? -0.011315313227834146f : -0.005646563141142063f)); }

struct EpiProj {
    static constexpr bool PERM = true, AFTER_DRAIN = false;
    bf16_t *upool, *q, *k, *v, *g, *xq, *gates; const float* cs;
    template <int KIND>
    __device__ __forceinline__ void run(const f32x4 (&acc)[2][2][4][2], bf16_t* base, int ld, int colt, int pm, int hbase, int wr, int wc, int fr, int fq) const {
        const int row0 = pm * BM + wr * 64 + fr, lc = wc * 32 + 8 * fq;
#pragma unroll
        for (int ai = 0; ai < 2; ++ai)
#pragma unroll
            for (int m = 0; m < 4; ++m) {
                const int row = row0 + ai * HALF + m * 16;
                bf16_t* rowp = base + (size_t)row * ld + colt + lc;
                f32x4 c0, c1;
                if (KIND >= 4) { const f32x4* cp = (const f32x4*)(cs + ((size_t)row * 64 + (lc >> 1)) * 2); c0 = cp[0]; c1 = cp[1]; }
#pragma unroll
                for (int bj = 0; bj < 2; ++bj) {
                    f32x4 v0 = acc[ai][bj][m][0], v1 = acc[ai][bj][m][1];
                    if (KIND == 1) { for (int e = 0; e < 4; ++e) { v0[e] = v0[e] * fast_sigmoid(v0[e]); v1[e] = v1[e] * fast_sigmoid(v1[e]); } }
                    else if (KIND == 2) { v0 = v0 * 0.08838834764831845f; v1 = v1 * 0.08838834764831845f; }
                    else if (KIND == 3) { for (int e = 0; e < 4; ++e) { v0[e] = fast_sigmoid(v0[e]); v1[e] = fast_sigmoid(v1[e]); } }
                    else if (KIND >= 4) {
                        const float cpos = (float)(row & (CH - 1)), l2g = log2_gamma(hbase + bj);
                        const float sc = (KIND == 4) ? __builtin_amdgcn_exp2f(cpos * l2g) : 0.08838834764831845f * __builtin_amdgcn_exp2f(-cpos * l2g);
                        f32x4 r0, r1;
                        r0[0] = (v0[0] * c0[0] - v0[1] * c0[1]) * sc; r0[1] = (v0[1] * c0[0] + v0[0] * c0[1]) * sc;
                        r0[2] = (v0[2] * c0[2] - v0[3] * c0[3]) * sc; r0[3] = (v0[3] * c0[2] + v0[2] * c0[3]) * sc;
                        r1[0] = (v1[0] * c1[0] - v1[1] * c1[1]) * sc; r1[1] = (v1[1] * c1[0] + v1[0] * c1[1]) * sc;
                        r1[2] = (v1[2] * c1[2] - v1[3] * c1[3]) * sc; r1[3] = (v1[3] * c1[2] + v1[2] * c1[3]) * sc;
                        v0 = r0; v1 = r1;
                    }
                    store8(rowp + bj * HALF, v0, v1);
                }
            }
    }
    __device__ __forceinline__ void operator()(const f32x4 (&acc)[2][2][4][2], const Unit& u, int wr, int wc, int fr, int fq) const {
        const int pn = u.pn;
        if (pn < 2) run<0>(acc, upool, 512, pn * 256, u.pm, 0, wr, wc, fr, fq);
        else if (pn < 4) run<4>(acc, q, 512, (pn - 2) * 256, u.pm, (pn - 2) * 2, wr, wc, fr, fq);
        else if (pn < 6) run<5>(acc, k, 512, (pn - 4) * 256, u.pm, (pn - 4) * 2, wr, wc, fr, fq);
        else if (pn < 10) run<0>(acc, v, 1024, (pn - 6) * 256, u.pm, 0, wr, wc, fr, fq);
        else if (pn < 14) run<1>(acc, g, 1024, (pn - 10) * 256, u.pm, 0, wr, wc, fr, fq);
        else if (pn < 16) run<2>(acc, xq, 512, (pn - 14) * 256, u.pm, 0, wr, wc, fr, fq);
        else run<3>(acc, gates, 3072, (pn - 16) * 256, u.pm, 0, wr, wc, fr, fq);
    }
};
}

namespace pg8 {
struct EpiMemKV {
    static constexpr bool PERM = true, AFTER_DRAIN = false;
    bf16_t *mk, *mv;
    __device__ __forceinline__ void operator()(const f32x4 (&acc)[2][2][4][2], const Unit& u, int wr, int wc, int fr, int fq) const {
        bf16_t* base = u.pn < 2 ? mk : mv; const int colt = (u.pn & 1) * 256;
        const int row0 = u.pm * BM + wr * 64 + fr, lc = wc * 32 + 8 * fq;
#pragma unroll
        for (int ai = 0; ai < 2; ++ai)
#pragma unroll
            for (int m = 0; m < 4; ++m) { bf16_t* rowp = base + (size_t)(row0 + ai * HALF + m * 16) * 512 + colt + lc;
#pragma unroll
                for (int bj = 0; bj < 2; ++bj) store8(rowp + bj * HALF, acc[ai][bj][m][0], acc[ai][bj][m][1]); }
    }
};
struct EpiPoolMap {
    static constexpr bool PERM = true, AFTER_DRAIN = false;
    bf16_t* ypool; const float* scale;
    __device__ __forceinline__ void operator()(const f32x4 (&acc)[2][2][4][2], const Unit& u, int wr, int wc, int fr, int fq) const {
        const int row0 = u.pm * BM + wr * 64 + fr, col0 = u.pn * 256 + wc * 32 + 8 * fq;
        f32x4 s[2][2];
#pragma unroll
        for (int bj = 0; bj < 2; ++bj) { s[bj][0] = *(const f32x4*)(scale + col0 + bj * HALF); s[bj][1] = *(const f32x4*)(scale + col0 + bj * HALF + 4); }
#pragma unroll
        for (int ai = 0; ai < 2; ++ai)
#pragma unroll
            for (int m = 0; m < 4; ++m) { bf16_t* rowp = ypool + (size_t)(row0 + ai * HALF + m * 16) * 512 + col0;
#pragma unroll
                for (int bj = 0; bj < 2; ++bj) store8(rowp + bj * HALF, acc[ai][bj][m][0] * s[bj][0], acc[ai][bj][m][1] * s[bj][1]); }
    }
};
__device__ __forceinline__ f32x4 bf4_to_f32(unsigned lo, unsigned hi) {
    f32x4 r; r[0] = __uint_as_float(lo << 16); r[1] = __uint_as_float(lo & 0xffff0000u); r[2] = __uint_as_float(hi << 16); r[3] = __uint_as_float(hi & 0xffff0000u); return r;
}
template <int MODE> struct EpiGate {
    static constexpr bool PERM = true, AFTER_DRAIN = false;
    float* accf; bf16_t* merged; const bf16_t* gates; int gofs;
    __device__ __forceinline__ void operator()(const f32x4 (&acc)[2][2][4][2], const Unit& u, int wr, int wc, int fr, int fq) const {
        const int row0 = u.pm * BM + wr * 64 + fr, col0 = u.pn * 256 + wc * 32 + 8 * fq;
#pragma unroll
        for (int ai = 0; ai < 2; ++ai)
#pragma unroll
            for (int m = 0; m < 4; ++m) { const size_t row = (size_t)(row0 + ai * HALF + m * 16);
#pragma unroll
                for (int bj = 0; bj < 2; ++bj) { const int c = col0 + bj * HALF;
                    const u32x4 gw = *(const u32x4*)(gates + row * 3072 + gofs + c);
                    f32x4 v0 = acc[ai][bj][m][0] * bf4_to_f32(gw.x, gw.y), v1 = acc[ai][bj][m][1] * bf4_to_f32(gw.z, gw.w);
                    float* ap = accf + row * 1024 + c;
                    if (MODE >= 1) { v0 += *(const f32x4*)ap; v1 += *(const f32x4*)(ap + 4); }
                    if (MODE <= 1) { *(f32x4*)ap = v0; *(f32x4*)(ap + 4) = v1; } else store8(merged + row * 1024 + c, v0, v1); }
                asm volatile("" ::: "memory"); }
    }
};
struct EpiResid {
    static constexpr bool PERM = true, AFTER_DRAIN = false;
    float* h; const float* x;
    __device__ __forceinline__ void operator()(const f32x4 (&acc)[2][2][4][2], const Unit& u, int wr, int wc, int fr, int fq) const {
        const int row0 = u.pm * BM + wr * 64 + fr, col0 = u.pn * 256 + wc * 32 + 8 * fq;
#pragma unroll
        for (int ai = 0; ai < 2; ++ai)
#pragma unroll
            for (int m = 0; m < 4; ++m) { const size_t o = (size_t)(row0 + ai * HALF + m * 16) * 1024 + col0;
#pragma unroll
                for (int bj = 0; bj < 2; ++bj) { const float* xp = x + o + bj * HALF; float* hp = h + o + bj * HALF;
                    *(f32x4*)hp = *(const f32x4*)xp * ALPHA + acc[ai][bj][m][0]; *(f32x4*)(hp + 4) = *(const f32x4*)(xp + 4) * ALPHA + acc[ai][bj][m][1]; }
                asm volatile("" ::: "memory"); }
    }
};
}

#define GAS __attribute__((address_space(1)))
#define LAS __attribute__((address_space(3)))
typedef unsigned v4u __attribute__((ext_vector_type(4)));
typedef unsigned v2u __attribute__((ext_vector_type(2)));
typedef float f32x4 __attribute__((ext_vector_type(4)));
typedef float f32x16 __attribute__((ext_vector_type(16)));
typedef short bf16x8 __attribute__((ext_vector_type(8)));
typedef short bf16x4 __attribute__((ext_vector_type(4)));
#define LDS_WAIT() asm volatile("s_waitcnt lgkmcnt(0)" ::: "memory")
#define VM_WAIT() asm volatile("s_waitcnt vmcnt(0)" ::: "memory")
__device__ __forceinline__ unsigned pk2(float lo, float hi) { return pg8::cvt_pk_bf16(lo, hi); }
constexpr int NWAVES = 8, NTHREADS = 512;
constexpr int RING_BYTES = 131072;
constexpr int MISC_OFF = 163840 - 256;
constexpr int LDS_BYTES = 163840;

#define XB_TMO      128
#define XB_XCNT(j)  (256  + 64 * (j))
#define XB_XSUB(j)  (1280 + 64 * (j))
#define XB_XGEN(j)  (2304 + 64 * (j))
#define XB_TOP      3328
#define XB_TOPGEN   3392
#define XCD_BAR_WORDS 3456
#define XB_SPIN_CAP (1u << 18)

__device__ __forceinline__ unsigned xb_ld(unsigned* p)              { return __hip_atomic_load(p, __ATOMIC_RELAXED, __HIP_MEMORY_SCOPE_AGENT); }
__device__ __forceinline__ unsigned xb_add(unsigned* p, unsigned v) { return __hip_atomic_fetch_add(p, v, __ATOMIC_RELAXED, __HIP_MEMORY_SCOPE_AGENT); }
__device__ __forceinline__ unsigned xb_xcc_id() { return (unsigned)__builtin_amdgcn_s_getreg((3 << 11) | 20) & 0xFu; }
#define XB_SPIN(cond, bar) do { unsigned _sp = 0; while (cond) { __builtin_amdgcn_s_sleep(1); \
    if ((++_sp & 255u) == 0u) { if (xb_ld(&(bar)[XB_TMO])) break; if (_sp > XB_SPIN_CAP) { atomicAdd(&(bar)[XB_TMO], 1u); break; } } } } while (0)

struct XcdBarrier {
    unsigned* bar; unsigned x;
    volatile LAS unsigned* st;
};

__device__ __forceinline__ XcdBarrier xcd_barrier_post(unsigned* bar, volatile LAS unsigned* st) {
    XcdBarrier b; b.bar = bar; b.x = xb_xcc_id(); b.st = st;
    if (threadIdx.x == 0) (void)xb_add(&bar[XB_XCNT(b.x)], 1u);
    return b;
}
__device__ __forceinline__ void xcd_barrier_complete(unsigned* bar, unsigned x, unsigned& nloc, unsigned& nx) {
    const unsigned G = gridDim.x * gridDim.y * gridDim.z;
    unsigned sum, cnt, mine, sp = 0u;
    for (;;) {
        sum = 0u; cnt = 0u; mine = 0u;
#pragma unroll
        for (unsigned j = 0; j < 16; ++j) { const unsigned c = xb_ld(&bar[XB_XCNT(j)]); sum += c; cnt += (c > 0u) ? 1u : 0u; mine = (j == x) ? c : mine; }
        if (sum == G) break;
        __builtin_amdgcn_s_sleep(1);
        if ((++sp & 255u) == 0u) { if (xb_ld(&bar[XB_TMO])) break; if (sp > XB_SPIN_CAP) { atomicAdd(&bar[XB_TMO], 1u); break; } }
    }
    nloc = mine > 0u ? mine : 1u; nx = cnt > 0u ? cnt : 1u;
}

__device__ __forceinline__ void xcd_barrier(const XcdBarrier& b) {
    asm volatile("s_waitcnt vmcnt(0)" ::: "memory");
    __syncthreads();
    if (threadIdx.x == 0) {
        unsigned* bar = b.bar;
        __builtin_amdgcn_s_waitcnt(0);
        unsigned nloc = b.st[0], nx = b.st[1];
        if (nloc == 0u) { xcd_barrier_complete(bar, b.x, nloc, nx); b.st[0] = nloc; b.st[1] = nx; }
        const unsigned old = xb_add(&bar[XB_XSUB(b.x)], 1u);
        const unsigned gen = old / nloc;
        if (old + 1u == (gen + 1u) * nloc) {
            __builtin_amdgcn_fence(__ATOMIC_RELEASE, "agent");
            asm volatile("s_waitcnt vmcnt(0)" ::: "memory");
            const unsigned og = xb_add(&bar[XB_TOP], 1u);
            const unsigned tg = og / nx;
            if (og + 1u == (tg + 1u) * nx) xb_add(&bar[XB_TOPGEN], 1u);
            else XB_SPIN(xb_ld(&bar[XB_TOPGEN]) == tg, bar);
            __builtin_amdgcn_fence(__ATOMIC_ACQUIRE, "agent");
            xb_add(&bar[XB_XGEN(b.x)], 1u);
            asm volatile("s_waitcnt vmcnt(0)" ::: "memory");
        } else {
            XB_SPIN(xb_ld(&bar[XB_XGEN(b.x)]) == gen, bar);
            __builtin_amdgcn_fence(__ATOMIC_ACQUIRE, "agent");
            asm volatile("s_waitcnt vmcnt(0)" ::: "memory");
        }
    }
    __syncthreads();
}

struct Args { const void* in[23]; float* out; unsigned char* ws; int ph_lo, ph_hi, li, pad; };
struct Ctx {
    LAS unsigned char* lds; int tid, lane, wave, G, vcu;
};
template <class F>
__device__ __forceinline__ void transpose_item(F colf, int ldw, bf16_t* WT, int K, int kb, int nb, LAS float* scr, int lane) {
    const int k0 = 64 * kb, n0 = 32 * nb;
    const float* cp = colf(n0 + (lane & 31)) + (size_t)k0 * ldw;
#pragma unroll 8
    for (int i = 0; i < 32; ++i) { const int kk = 2 * i + (lane >> 5); scr[kk * 33 + (lane & 31)] = cp[(size_t)kk * ldw]; }
    LDS_WAIT(); asm volatile("" ::: "memory");
    const int c = lane & 7;
#pragma unroll
    for (int j = 0; j < 4; ++j) { const int n = (lane >> 3) + 8 * j; const LAS float* s = scr + (8 * c) * 33 + n;
        v4u o; o.x = pk2(s[0 * 33], s[1 * 33]); o.y = pk2(s[2 * 33], s[3 * 33]); o.z = pk2(s[4 * 33], s[5 * 33]); o.w = pk2(s[6 * 33], s[7 * 33]);
        *(v4u*)(WT + (size_t)(n0 + n) * K + k0 + 8 * c) = o; }
    LDS_WAIT(); asm volatile("" ::: "memory");
}
struct ColPlain { const float* w; __device__ __forceinline__ const float* operator()(int n) const { return w + n; } };
struct ColWin {
    const float* w;
    __device__ __forceinline__ const float* operator()(int n) const {
        int src = n;
        if (n >= 512 && n < 1536) { const int r = (n - 512) & 511, sec = (n - 512) >> 9, hh = r >> 7, p = r & 127; src = 512 + sec * 512 + hh * 128 + (p >> 1) + 64 * (p & 1); }
        return w + src;
    }
};
__device__ __forceinline__ void f32_to_bf16_range(const float* in, bf16_t* out, size_t n4, size_t gtid, size_t nthr) {
    for (size_t i = gtid; i < n4; i += nthr) { const f32x4 v = ((const f32x4*)in)[i]; v2u o; o.x = pk2(v[0], v[1]); o.y = pk2(v[2], v[3]); ((v2u*)out)[i] = o; }
}
__device__ __forceinline__ void p0_prologue(const Ctx& C, const Args& a) {
    const float* x = (const float*)a.in[0]; const float* mem = (const float*)a.in[1]; const int* positions = (const int*)a.in[2];
    const float* w_in = (const float*)a.in[3]; const float* w_pool_grp = (const float*)a.in[4]; const float* w_mem_kv = (const float*)a.in[7];
    const float* w_br_pool = (const float*)a.in[8]; const float* w_br_ret = (const float*)a.in[9]; const float* w_br_xa = (const float*)a.in[10]; const float* w_out = (const float*)a.in[11];
    unsigned char* dout = (unsigned char*)a.out; unsigned char* ws = a.ws;
    LAS float* scr = (LAS float*)(C.lds + C.wave * 16384);
    const int gw = C.vcu * NWAVES + C.wave, NGW = C.G * NWAVES;
    constexpr int I_WIN = 16 * 224, I_WMEM = 16 * 32, I_WP = 8 * 32, I_WR = 16 * 32, I_WX = 8 * 32, I_WO = 16 * 32;
    constexpr int NITEMS = I_WIN + I_WMEM + I_WP + I_WR + I_WX + I_WO;
    for (int it = gw; it < NITEMS; it += NGW) {
        int r = it;
        if (r < I_WIN) { transpose_item(ColWin{w_in}, NIN, (bf16_t*)(dout + DO_WINT), 1024, r / 224, r % 224, scr, C.lane); continue; } r -= I_WIN;
        if (r < I_WMEM) { transpose_item(ColPlain{w_mem_kv}, 1024, (bf16_t*)(dout + DO_WMEMT), 1024, r / 32, r % 32, scr, C.lane); continue; } r -= I_WMEM;
        if (r < I_WP) { transpose_item(ColPlain{w_br_pool}, 1024, (bf16_t*)(ws + WS_WPT), 512, r / 32, r % 32, scr, C.lane); continue; } r -= I_WP;
        if (r < I_WR) { transpose_item(ColPlain{w_br_ret}, 1024, (bf16_t*)(ws + WS_WRT), 1024, r / 32, r % 32, scr, C.lane); continue; } r -= I_WR;
        if (r < I_WX) { transpose_item(ColPlain{w_br_xa}, 1024, (bf16_t*)(ws + WS_WXT), 512, r / 32, r % 32, scr, C.lane); continue; } r -= I_WX;
        transpose_item(ColPlain{w_out}, 1024, (bf16_t*)(ws + WS_WOUTT), 1024, r / 32, r % 32, scr, C.lane);
    }
    const size_t gtid = (size_t)C.vcu * NTHREADS + C.tid, nthr = (size_t)C.G * NTHREADS;
    f32_to_bf16_range(x, (bf16_t*)(dout + DO_XB), (size_t)T * 1024 / 4, gtid, nthr);
    f32_to_bf16_range(mem, (bf16_t*)(dout + DO_MEMB), (size_t)BATCH * MEML * 1024 / 4, gtid, nthr);
    { bf16_t* wbd = (bf16_t*)(ws + WS_WPOOLBD);
      for (size_t i = gtid; i < 512 * 512; i += nthr) { const int n = (int)(i >> 9), k = (int)(i & 511);
          wbd[i] = ((n >> 7) == (k >> 7)) ? f2bf(w_pool_grp[((size_t)(n >> 7) * 128 + (k & 127)) * 128 + (n & 127)]) : (bf16_t)0; } }
    { float* cs = (float*)(dout + DO_CS); const int j = (int)(gtid & 63);
      const double invf = (double)(float)pow(10000.0, -(double)j / 64.0);
      for (size_t i = gtid; i < (size_t)T * 64; i += nthr) { const int t = (int)(i >> 6); const double ang = (double)positions[t] * invf;
          cs[2 * i] = (float)cos(ang); cs[2 * i + 1] = (float)sin(ang); } }
}

namespace pg8 {
template <bool GATHER> struct MoeSched {
    const PG8_LAS int* base;
    const int* cnt; const int* lists;
    const char* A; const char* Bt; size_t b_estride;
    int K, NP, G, c;
    __device__ __forceinline__ bool next(int i, UnitG& u) const {
        const int ntr = base[32] >> 8, L = i * G + c;
        if (L >= ntr * NP) return false;
        const int rt = L / NP;
        u.pm = rt; u.pn = L - rt * NP; u.e = base[40 + rt]; return true;
    }
    __device__ __forceinline__ const char* a_base(const UnitG& u) const { return GATHER ? A : A + (size_t)u.pm * 256 * K * 2; }
    __device__ __forceinline__ const char* b_base(const UnitG& u) const { return Bt + (size_t)u.e * b_estride + (size_t)u.pn * 256 * K * 2; }
    __device__ __forceinline__ unsigned a_voff(const UnitG& u, int R, int C, int half) const {
        if (!GATHER) return (unsigned)((half * 128 + R) * K + C) * 2u;
        const int slot = u.pm * 256 + half * 128 + R - base[u.e], n = cnt[u.e];
        const int tok = lists[(size_t)u.e * T + (slot < n ? slot : 0)];
        return (unsigned)(tok * K + C) * 2u;
    }
};
struct MoeOrder {
    const PG8_LAS int* base; int NP, G, c;
    __device__ __forceinline__ bool next(int i, Unit& u) const {
        const int ntr = base[32] >> 8, L = i * G + c;
        if (L >= ntr * NP) return false;
        const int rt = L / NP, e = base[40 + rt];
        u.pm = rt; u.pn = e * NP + (L - rt * NP); return true;
    }
    __device__ __forceinline__ void a_ready(const Unit&) const {}
    __device__ __forceinline__ void done(const Unit&) const {}
};
struct EpiMoeAct {
    static constexpr bool PERM = true, AFTER_DRAIN = false;
    bf16_t* act;
    __device__ __forceinline__ void operator()(const f32x4 (&acc)[2][2][4][2], const Unit& u, int wr, int wc, int fr, int fq) const {
        const int row0 = u.pm * BM + wr * 64 + fr, c8 = u.pn * 256 + wc * 32 + 8 * fq;
#pragma unroll
        for (int ai = 0; ai < 2; ++ai)
#pragma unroll
            for (int m = 0; m < 4; ++m) { bf16_t* rowp = act + (size_t)(row0 + ai * HALF + m * 16) * 256;
#pragma unroll
                for (int bj = 0; bj < 2; ++bj) { const f32x4 gt = acc[ai][bj][m][0], up = acc[ai][bj][m][1]; f32x4 o;
#pragma unroll
                    for (int e = 0; e < 4; ++e) o[e] = gt[e] * fast_sigmoid(gt[e]) * up[e];
                    u32x2 w; w.x = cvt_pk_bf16(o[0], o[1]); w.y = cvt_pk_bf16(o[2], o[3]);
                    *(u32x2*)(rowp + ((c8 + bj * HALF) >> 1)) = w; } }
    }
};
struct EpiMoeY {
    static constexpr bool PERM = true, AFTER_DRAIN = false;
    bf16_t* y;
    __device__ __forceinline__ void operator()(const f32x4 (&acc)[2][2][4][2], const Unit& u, int wr, int wc, int fr, int fq) const {
        const int row0 = u.pm * BM + wr * 64 + fr, col0 = (u.pn & 3) * 256 + wc * 32 + 8 * fq;
#pragma unroll
        for (int ai = 0; ai < 2; ++ai)
#pragma unroll
            for (int m = 0; m < 4; ++m) { bf16_t* rowp = y + (size_t)(row0 + ai * HALF + m * 16) * 1024 + col0;
#pragma unroll
                for (int bj = 0; bj < 2; ++bj) store8(rowp + bj * HALF, acc[ai][bj][m][0], acc[ai][bj][m][1]); }
    }
};
}
struct ColMoe1 {
    unsigned long long wg, delta;
    __device__ __forceinline__ const float* operator()(int n) const { const int m = n >> 3, j = n & 7; const unsigned long long p = wg + ((j >= 4) ? delta : 0ull); return (const float*)p + 4 * m + (j & 3); }
};
__device__ __forceinline__ void moe_convert_weights(const Ctx& C, const Args& a) {
    const float* w_eg = (const float*)a.in[18]; const float* w_eu = (const float*)a.in[19]; const float* w_ed = (const float*)a.in[20];
    bf16_t* w1 = (bf16_t*)(a.ws + WS_MOEW1); bf16_t* w2 = (bf16_t*)(a.ws + WS_MOEW2);
    LAS float* scr = (LAS float*)(C.lds + C.wave * 16384);
    const int gw = C.vcu * NWAVES + C.wave, NGW = C.G * NWAVES;
    for (int it = gw; it < 12288; it += NGW) {
        if (it < 8192) { const int e = it >> 8, r = it & 255;
            transpose_item(ColMoe1{(unsigned long long)(w_eg + (size_t)e * 262144), (unsigned long long)w_eu - (unsigned long long)w_eg}, 256, w1 + (size_t)e * 524288, 1024, r >> 4, r & 15, scr, C.lane); }
        else { const int r = it - 8192, e = r >> 7, rr = r & 127;
            transpose_item(ColPlain{w_ed + (size_t)e * 262144}, 1024, w2 + (size_t)e * 262144, 256, rr >> 5, rr & 31, scr, C.lane); }
    }
}
__device__ __forceinline__ void compute_base(const Ctx& C, const int* cnt, LAS int* base) {
    if (C.wave == 0) {
        const int c = C.lane < 32 ? cnt[C.lane] : 0, p = (c + 255) & ~255; int incl = p;
#pragma unroll
        for (int o = 1; o < 32; o <<= 1) { const int t = __shfl_up(incl, o); if (C.lane >= o) incl += t; }
        if (C.lane < 32) base[C.lane] = incl - p;
        if (C.lane == 31) base[32] = incl;
    }
    __syncthreads();
    if (C.tid < 160) { const int r0 = C.tid << 8; int e = 0;
#pragma unroll 1
        for (int j = 1; j < 32; ++j) e = (base[j] <= r0) ? j : e;
        base[40 + C.tid] = e; }
    __syncthreads();
}

struct TokInfo { int e0, e1, s0, s1; float w0, w1; int pad0, pad1; };
__device__ __forceinline__ float wave_sum(float v) {
#pragma unroll
    for (int o = 1; o < 64; o <<= 1) v += __shfl_xor(v, o);
    return v;
}
constexpr int RW_STRIDE = 1024;
__device__ __forceinline__ void p5_ln1_router(const Ctx& C, const Args& a) {
    float* hx = a.out; bf16_t* x1b = (bf16_t*)(a.ws + WS_X1B);
    const float* ln_w = (const float*)a.in[12]; const float* ln_b = (const float*)a.in[13];
    const float* wgr = (const float*)a.in[14]; const float* bgr = (const float*)a.in[15]; const float* wer = (const float*)a.in[16]; const float* ber = (const float*)a.in[17];
    int* cnt = (int*)(a.ws + WS_CTL) + CW_CNT; int* lists = (int*)(a.ws + WS_LISTS); TokInfo* info = (TokInfo*)(a.ws + WS_TOKINFO);
    moe_convert_weights(C, a);
    __syncthreads();
    LAS float* Wl = (LAS float*)C.lds;
    for (int i = C.tid; i < 1024 * 36; i += NTHREADS) { const int k = i / 36, j = i % 36; Wl[j * RW_STRIDE + k] = j < 4 ? wgr[k * 4 + j] : wer[k * 32 + (j - 4)]; }
    __syncthreads();
    const int lane = C.lane;
    f32x4 lw[4], lb[4];
#pragma unroll
    for (int q = 0; q < 4; ++q) { lw[q] = *(const f32x4*)(ln_w + 256 * q + 4 * lane); lb[q] = *(const f32x4*)(ln_b + 256 * q + 4 * lane); }
    const int gw = C.vcu * NWAVES + C.wave, NGW = C.G * NWAVES;
    for (int t = gw; t < T; t += NGW) {
        float* row = hx + (size_t)t * 1024;
        f32x4 v[4]; float s = 0.f;
#pragma unroll
        for (int q = 0; q < 4; ++q) { v[q] = *(const f32x4*)(row + 256 * q + 4 * lane); s += (v[q][0] + v[q][1]) + (v[q][2] + v[q][3]); }
        const float mu = wave_sum(s) * (1.f / 1024.f); float sq = 0.f;
#pragma unroll
        for (int q = 0; q < 4; ++q) { v[q] = v[q] - mu; sq += (v[q][0] * v[q][0] + v[q][1] * v[q][1]) + (v[q][2] * v[q][2] + v[q][3] * v[q][3]); }
        const float rstd = rsqrtf(wave_sum(sq) * (1.f / 1024.f) + LN_EPS);
#pragma unroll
        for (int q = 0; q < 4; ++q) { v[q] = v[q] * rstd * lw[q] + lb[q]; *(f32x4*)(row + 256 * q + 4 * lane) = v[q];
            v2u o; o.x = pk2(v[q][0], v[q][1]); o.y = pk2(v[q][2], v[q][3]); *(v2u*)(x1b + (size_t)t * 1024 + 256 * q + 4 * lane) = o; }
        float lg[4];
#pragma unroll
        for (int j = 0; j < 4; ++j) { float p = 0.f;
#pragma unroll
            for (int q = 0; q < 4; ++q) { const f32x4 w = *(const LAS f32x4*)(Wl + j * RW_STRIDE + 256 * q + 4 * lane); p += (v[q][0] * w[0] + v[q][1] * w[1]) + (v[q][2] * w[2] + v[q][3] * w[3]); }
            lg[j] = wave_sum(p) + bgr[j]; }
        float m = lg[0]; int gs = 0;
#pragma unroll
        for (int j = 1; j < 4; ++j) if (lg[j] > m) { m = lg[j]; gs = j; }
        float den = 0.f;
#pragma unroll
        for (int j = 0; j < 4; ++j) den += __expf(lg[j] - m);
        const float pg = 1.f / den;
        gs = __builtin_amdgcn_readfirstlane(gs);
        float el[8];
        const LAS float* We = Wl + (4 + gs * 8) * RW_STRIDE;
#pragma unroll
        for (int j = 0; j < 8; ++j) { float p = 0.f;
#pragma unroll
            for (int q = 0; q < 4; ++q) { const f32x4 w = *(const LAS f32x4*)(We + j * RW_STRIDE + 256 * q + 4 * lane); p += (v[q][0] * w[0] + v[q][1] * w[1]) + (v[q][2] * w[2] + v[q][3] * w[3]); }
            el[j] = wave_sum(p) + ber[gs * 8 + j]; }
        int i0 = 0; float v0 = el[0];
#pragma unroll
        for (int j = 1; j < 8; ++j) if (el[j] > v0) { v0 = el[j]; i0 = j; }
        int i1 = -1; float v1 = -3.0e38f;
#pragma unroll
        for (int j = 0; j < 8; ++j) if (j != i0 && el[j] > v1) { v1 = el[j]; i1 = j; }
        if (i1 < 0) i1 = (i0 == 0) ? 1 : 0;
        const float e1 = __expf(v1 - v0);
        if (lane == 0) {
            TokInfo ti; ti.e0 = gs * 8 + i0; ti.e1 = gs * 8 + i1; ti.w0 = pg / (1.f + e1); ti.w1 = pg * e1 / (1.f + e1); ti.pad0 = 0; ti.pad1 = 0;
            ti.s0 = atomicAdd(&cnt[ti.e0], 1); ti.s1 = atomicAdd(&cnt[ti.e1], 1);
            lists[ti.e0 * T + ti.s0] = t; lists[ti.e1 * T + ti.s1] = t;
            info[t] = ti;
        }
    }
}
__device__ __forceinline__ void p7_final(const Ctx& C, const Args& a, const LAS int* base) {
    float* x1 = a.out; const bf16_t* y = (const bf16_t*)(a.ws + WS_Y); const TokInfo* info = (const TokInfo*)(a.ws + WS_TOKINFO);
    const float* ln_w = (const float*)a.in[21]; const float* ln_b = (const float*)a.in[22];
    const int lane = C.lane;
    f32x4 lw[4], lb[4];
#pragma unroll
    for (int q = 0; q < 4; ++q) { lw[q] = *(const f32x4*)(ln_w + 256 * q + 4 * lane); lb[q] = *(const f32x4*)(ln_b + 256 * q + 4 * lane); }
    const int gw = C.vcu * NWAVES + C.wave, NGW = C.G * NWAVES;
    for (int t = gw; t < T; t += NGW) {
        const TokInfo ti = info[t];
        const bf16_t* y0 = y + (size_t)(base[ti.e0] + ti.s0) * 1024; const bf16_t* y1 = y + (size_t)(base[ti.e1] + ti.s1) * 1024;
        float* row = x1 + (size_t)t * 1024;
        f32x4 v[4]; float s = 0.f;
#pragma unroll
        for (int q = 0; q < 4; ++q) { const int c = 256 * q + 4 * lane; const v2u a0 = *(const v2u*)(y0 + c), a1 = *(const v2u*)(y1 + c);
            v[q] = *(const f32x4*)(row + c) * ALPHA + pg8::bf4_to_f32(a0.x, a0.y) * ti.w0 + pg8::bf4_to_f32(a1.x, a1.y) * ti.w1;
            s += (v[q][0] + v[q][1]) + (v[q][2] + v[q][3]); }
        const float mu = wave_sum(s) * (1.f / 1024.f); float sq = 0.f;
#pragma unroll
        for (int q = 0; q < 4; ++q) { v[q] = v[q] - mu; sq += (v[q][0] * v[q][0] + v[q][1] * v[q][1]) + (v[q][2] * v[q][2] + v[q][3] * v[q][3]); }
        const float rstd = rsqrtf(wave_sum(sq) * (1.f / 1024.f) + LN_EPS);
#pragma unroll
        for (int q = 0; q < 4; ++q) *(f32x4*)(row + 256 * q + 4 * lane) = v[q] * rstd * lw[q] + lb[q];
    }
}

typedef short s16x4 __attribute__((ext_vector_type(4)));
#define MFMA32(a, b, c) __builtin_amdgcn_mfma_f32_32x32x16_bf16((a), (b), (c), 0, 0, 0)
__device__ __forceinline__ int crow(int i, int h) { return (i & 3) + 8 * (i >> 2) + 4 * h; }
__device__ __forceinline__ bf16x8 pack8(const f32x16& x, int s) {
    v4u p; p.x = pk2(x[8 * s], x[8 * s + 1]); p.y = pk2(x[8 * s + 2], x[8 * s + 3]); p.z = pk2(x[8 * s + 4], x[8 * s + 5]); p.w = pk2(x[8 * s + 6], x[8 * s + 7]);
    return __builtin_bit_cast(bf16x8, p);
}
__device__ __forceinline__ bf16x8 cvt8(const f32x4& a, const f32x4& b) { v4u p; p.x = pk2(a[0], a[1]); p.y = pk2(a[2], a[3]); p.z = pk2(b[0], b[1]); p.w = pk2(b[2], b[3]); return __builtin_bit_cast(bf16x8, p); }
__device__ __forceinline__ bf16x8 tr_frag(LAS unsigned char* img, int pitch, int k0, int k1, int mn0, int lane) {
    const int q4 = (lane & 15) >> 2, p4 = lane & 3, blk = (lane >> 4) & 1, cb = (mn0 + 16 * blk + 4 * p4) * 2;
    const s16x4 lo = __builtin_amdgcn_ds_read_tr16_b64_v4i16((LAS s16x4*)(img + (k0 + q4) * pitch + cb));
    const s16x4 hi = __builtin_amdgcn_ds_read_tr16_b64_v4i16((LAS s16x4*)(img + (k1 + q4) * pitch + cb));
    return __builtin_shufflevector(lo, hi, 0, 1, 2, 3, 4, 5, 6, 7);
}
__device__ __forceinline__ float gamma_log2(int h) { return pg8::log2_gamma(h); }

__device__ __forceinline__ void pooled_strip(const Ctx& C, const bf16_t* up, bf16_t* pooled, int strip) {
    const int c = C.tid, w = 2 << (c >> 7), t0 = strip * 64, s0 = t0 & (SEQ - 1);
    float sum = 0.f;
    for (int j = 1; j <= w; ++j) if (s0 - j >= 0) sum += bf2f(up[(size_t)(t0 - j) * 512 + c]);
#pragma unroll 4
    for (int i = 0; i < 64; ++i) { const int t = t0 + i, s = s0 + i; const float cur = bf2f(up[(size_t)t * 512 + c]);
        sum += cur; if (s - w >= 0) sum -= bf2f(up[(size_t)(t - w) * 512 + c]);
        const int n = (s + 1 < w) ? s + 1 : w;
        pooled[(size_t)t * 512 + c] = f2bf(sum / (float)n - cur); }
}
__device__ __forceinline__ void xattn_unit(const Ctx& C, bf16_t* xq, const bf16_t* mk, const bf16_t* mv, int unit) {
    const int qt = unit & 15, h = (unit >> 4) & 3, b = unit >> 6;
    LAS unsigned char* Kl = C.lds; LAS unsigned char* Vl = C.lds + 69632;
#pragma unroll
    for (int it = 0; it < 8; ++it) { const int idx = C.tid + it * 512, row = idx >> 4, ch = idx & 15;
        const size_t src = ((size_t)(b * MEML + row) * 512 + h * 128) * 2 + ch * 16;
        const v4u kv = *(const v4u*)((const char*)mk + src), vv = *(const v4u*)((const char*)mv + src);
        *(LAS v4u*)(Kl + row * 272 + ch * 16) = kv; *(LAS v4u*)(Vl + row * 320 + ch * 16) = vv; }
    __syncthreads();
    const int lane = C.lane, r = lane & 31, h2 = lane >> 5;
    bf16_t* qrow = xq + ((size_t)b * SEQ + qt * 256 + C.wave * 32 + r) * 512 + h * 128;
    bf16x8 qf[8];
#pragma unroll
    for (int ks = 0; ks < 8; ++ks) qf[ks] = *(const bf16x8*)(qrow + 16 * ks + 8 * h2);
    f32x16 ot[4];
#pragma unroll
    for (int db = 0; db < 4; ++db)
#pragma unroll
        for (int i = 0; i < 16; ++i) ot[db][i] = 0.f;
    float m_run = -3.0e38f, sum = 0.f;
#pragma unroll 1
    for (int qtr = 0; qtr < 4; ++qtr) {
        f32x16 st[2];
#pragma unroll
        for (int kq = 0; kq < 2; ++kq) { LAS unsigned char* kp = Kl + (64 * qtr + 32 * kq + r) * 272 + 16 * h2;
#pragma unroll
            for (int i = 0; i < 16; ++i) st[kq][i] = 0.f;
#pragma unroll
            for (int ks = 0; ks < 8; ++ks) { const bf16x8 kf = *(const LAS bf16x8*)(kp + 32 * ks); st[kq] = MFMA32(kf, qf[ks], st[kq]); }
        }
        float mh = -3.0e38f;
#pragma unroll
        for (int kq = 0; kq < 2; ++kq)
#pragma unroll
            for (int i = 0; i < 16; ++i) mh = fmaxf(mh, st[kq][i]);
        mh = fmaxf(mh, __shfl_xor(mh, 32));
        const float m_new = fmaxf(m_run, mh), alpha = __builtin_amdgcn_exp2f((m_run - m_new) * 1.4426950408889634f);
        sum *= alpha;
#pragma unroll
        for (int db = 0; db < 4; ++db)
#pragma unroll
            for (int i = 0; i < 16; ++i) ot[db][i] *= alpha;
        m_run = m_new;
#pragma unroll
        for (int kq = 0; kq < 2; ++kq)
#pragma unroll
            for (int i = 0; i < 16; ++i) { const float p = __builtin_amdgcn_exp2f((st[kq][i] - m_new) * 1.4426950408889634f); st[kq][i] = p; sum += p; }
#pragma unroll
        for (int kq = 0; kq < 2; ++kq)
#pragma unroll
            for (int s = 0; s < 2; ++s) { const bf16x8 pb = pack8(st[kq], s); const int k0 = 64 * qtr + 32 * kq + 16 * s + 4 * h2;
#pragma unroll
                for (int db = 0; db < 4; ++db) { const bf16x8 vf = tr_frag(Vl, 320, k0, k0 + 8, 32 * db, lane); ot[db] = MFMA32(vf, pb, ot[db]); } }
    }
    sum += __shfl_xor(sum, 32);
    const float inv = 1.f / sum;
#pragma unroll
    for (int db = 0; db < 4; ++db)
#pragma unroll
        for (int gq = 0; gq < 4; ++gq) { v2u w; w.x = pk2(ot[db][4 * gq] * inv, ot[db][4 * gq + 1] * inv); w.y = pk2(ot[db][4 * gq + 2] * inv, ot[db][4 * gq + 3] * inv);
            *(v2u*)(qrow + 32 * db + 8 * gq + 4 * h2) = w; }
    __syncthreads();
}
template <bool WITH_K>
__device__ __forceinline__ void stage_chunk(const Ctx& C, const bf16_t* k, const bf16_t* v, size_t t0, int h) {
#pragma unroll
    for (int it = 0; it < 8; ++it) { const int idx = C.tid + it * 512, row = idx >> 5, ch = idx & 31;
        const v4u x = *(const v4u*)(v + (t0 + row) * 1024 + h * 256 + ch * 8); *(LAS v4u*)(C.lds + row * 576 + ch * 16) = x; }
    if (WITH_K) {
#pragma unroll
        for (int it = 0; it < 4; ++it) { const int idx = C.tid + it * 512, row = idx >> 4, ch = idx & 15;
            const v4u x = *(const v4u*)(k + (t0 + row) * 512 + h * 128 + ch * 8); *(LAS v4u*)(C.lds + 73728 + row * 320 + ch * 16) = x; }
    }
}
__device__ __forceinline__ void ret_state_unit(const Ctx& C, const bf16_t* k, const bf16_t* v, float* kvT, int u) {
    const int h = u & 3; const size_t t0 = (size_t)(u >> 2) * CH;
    stage_chunk<true>(C, k, v, t0, h);
    __syncthreads();
    LAS unsigned char* Vl = C.lds; LAS unsigned char* Kl = C.lds + 73728;
    const int lane = C.lane, r = lane & 31, h2 = lane >> 5, eb = C.wave;
    f32x16 acc[4];
#pragma unroll
    for (int db = 0; db < 4; ++db)
#pragma unroll
        for (int i = 0; i < 16; ++i) acc[db][i] = 0.f;
#pragma unroll
    for (int ks = 0; ks < 8; ++ks) { const int k0 = 16 * ks + 8 * h2;
        const bf16x8 af = tr_frag(Vl, 576, k0, k0 + 4, 32 * eb, lane);
#pragma unroll
        for (int db = 0; db < 4; ++db) { const bf16x8 bf = tr_frag(Kl, 320, k0, k0 + 4, 32 * db, lane); acc[db] = MFMA32(af, bf, acc[db]); } }
    const float sc = __builtin_amdgcn_exp2f((float)(CH - 1) * gamma_log2(h));
    float* out = kvT + ((size_t)u * 256 + 32 * eb) * 128 + r;
#pragma unroll
    for (int db = 0; db < 4; ++db)
#pragma unroll
        for (int i = 0; i < 16; ++i) out[(size_t)crow(i, h2) * 128 + 32 * db] = acc[db][i] * sc;
    __syncthreads();
}
__device__ __forceinline__ void scan_all(const Ctx& C, float* kvT) {
    const size_t nthr = (size_t)C.G * NTHREADS;
    for (size_t idx = (size_t)C.vcu * NTHREADS + C.tid; idx < (size_t)BATCH * 4 * 8192; idx += nthr) {
        const int ed4 = (int)(idx & 8191), h = (int)((idx >> 13) & 3), b = (int)(idx >> 15);
        const float cd = __builtin_amdgcn_exp2f((float)CH * gamma_log2(h));
        f32x4 inc[NCH];
#pragma unroll
        for (int n = 0; n < NCH; ++n) inc[n] = *(const f32x4*)(kvT + ((size_t)((b * NCH + n) * 4 + h)) * 32768 + ed4 * 4);
        f32x4 st = {0.f, 0.f, 0.f, 0.f};
#pragma unroll
        for (int n = 0; n < NCH; ++n) { *(f32x4*)(kvT + ((size_t)((b * NCH + n) * 4 + h)) * 32768 + ed4 * 4) = st; st = st * cd + inc[n]; }
    }
}
__device__ __forceinline__ void ret_out_unit(const Ctx& C, const bf16_t* q, const bf16_t* k, const bf16_t* v, const float* prevT, bf16_t* g, const float* gn_w, int u) {
    const int h = u & 3; const size_t t0 = (size_t)(u >> 2) * CH;
    stage_chunk<false>(C, k, v, t0, h);
    __syncthreads();
    LAS unsigned char* Vl = C.lds; LAS float* red = (LAS float*)(C.lds + 73728);
    const int lane = C.lane, r = lane & 31, h2 = lane >> 5, cb = C.wave & 3, eh = C.wave >> 2;
    const size_t tokq = t0 + 32 * cb + r;
    const bf16_t* qrow = q + tokq * 512 + h * 128;
    bf16x8 qf[8];
#pragma unroll
    for (int ks = 0; ks < 8; ++ks) qf[ks] = *(const bf16x8*)(qrow + 16 * ks + 8 * h2);
    f32x16 yt[4];
#pragma unroll
    for (int el = 0; el < 4; ++el)
#pragma unroll
        for (int i = 0; i < 16; ++i) yt[el][i] = 0.f;
#pragma unroll
    for (int ks = 0; ks < 8; ++ks)
#pragma unroll
        for (int el = 0; el < 4; ++el) { const float* pr = prevT + ((size_t)u * 256 + 32 * (4 * eh + el) + r) * 128 + 16 * ks + 8 * h2;
            const bf16x8 af = cvt8(*(const f32x4*)pr, *(const f32x4*)(pr + 4)); yt[el] = MFMA32(af, qf[ks], yt[el]); }
    const float gam = __builtin_amdgcn_exp2f(gamma_log2(h));
#pragma unroll
    for (int el = 0; el < 4; ++el)
#pragma unroll
        for (int i = 0; i < 16; ++i) yt[el][i] *= gam;
    for (int sb = 0; sb <= cb; ++sb) {
        f32x16 sblk;
#pragma unroll
        for (int i = 0; i < 16; ++i) sblk[i] = 0.f;
        const bf16_t* krow = k + (t0 + 32 * sb + r) * 512 + h * 128;
#pragma unroll
        for (int ks = 0; ks < 8; ++ks) { const bf16x8 kf = *(const bf16x8*)(krow + 16 * ks + 8 * h2); sblk = MFMA32(kf, qf[ks], sblk); }
        if (sb == cb) {
#pragma unroll
            for (int i = 0; i < 16; ++i) sblk[i] = (crow(i, h2) > r) ? 0.f : sblk[i];
        }
#pragma unroll
        for (int s = 0; s < 2; ++s) { const bf16x8 pb = pack8(sblk, s); const int k0 = 32 * sb + 16 * s + 4 * h2;
#pragma unroll
            for (int el = 0; el < 4; ++el) { const bf16x8 vf = tr_frag(Vl, 576, k0, k0 + 8, 32 * (4 * eh + el), lane); yt[el] = MFMA32(vf, pb, yt[el]); } }
    }
    float s1 = 0.f;
#pragma unroll
    for (int el = 0; el < 4; ++el)
#pragma unroll
        for (int i = 0; i < 16; ++i) s1 += yt[el][i];
    s1 += __shfl_xor(s1, 32);
    if (h2 == 0) red[C.wave * 32 + r] = s1;
    __syncthreads();
    const float mean = (s1 + red[(C.wave ^ 4) * 32 + r]) * (1.f / 256.f);
    float s2 = 0.f;
#pragma unroll
    for (int el = 0; el < 4; ++el)
#pragma unroll
        for (int i = 0; i < 16; ++i) { const float d = yt[el][i] - mean; s2 += d * d; }
    s2 += __shfl_xor(s2, 32);
    if (h2 == 0) red[256 + C.wave * 32 + r] = s2;
    __syncthreads();
    const float rstd = rsqrtf((s2 + red[256 + (C.wave ^ 4) * 32 + r]) * (1.f / 256.f) + LN_EPS);
    bf16_t* grow = g + tokq * 1024 + h * 256;
#pragma unroll
    for (int el = 0; el < 4; ++el)
#pragma unroll
        for (int gq = 0; gq < 4; ++gq) { const int e0 = 32 * (4 * eh + el) + 8 * gq + 4 * h2;
            const f32x4 w = *(const f32x4*)(gn_w + h * 256 + e0); const v2u gs = *(const v2u*)(grow + e0); const f32x4 gf = pg8::bf4_to_f32(gs.x, gs.y);
            f32x4 o;
#pragma unroll
            for (int j = 0; j < 4; ++j) o[j] = (yt[el][4 * gq + j] - mean) * rstd * w[j] * gf[j];
            v2u ow; ow.x = pk2(o[0], o[1]); ow.y = pk2(o[2], o[3]); *(v2u*)(grow + e0) = ow; }
    __syncthreads();
}

__global__ void __launch_bounds__(NTHREADS, 2) mega(Args a) {
    extern __shared__ __attribute__((aligned(16))) unsigned char lds_raw[];
    Ctx C; C.lds = (LAS unsigned char*)lds_raw; C.tid = threadIdx.x; C.lane = C.tid & 63; C.wave = __builtin_amdgcn_readfirstlane(C.tid >> 6);
    C.G = gridDim.x; { const int bx = blockIdx.x; C.vcu = (C.G % 8 == 0) ? (bx % 8) * (C.G / 8) + bx / 8 : bx; }
    volatile LAS unsigned* MISC = (volatile LAS unsigned*)(C.lds + MISC_OFF);
    if (C.tid < 64) MISC[C.tid] = 0u;
    __syncthreads();
    XcdBarrier bar = xcd_barrier_post((unsigned*)(a.ws + WS_CTL) + CW_BAR + a.li * XCD_BAR_WORDS, MISC + 8);
    const int lo = a.ph_lo, hi = a.ph_hi;
#define IN(k) (lo <= (k) && (k) < hi)
#define BOTH(k) (IN(k) && IN((k) + 1))
    unsigned char* dout = (unsigned char*)a.out; unsigned char* ws = a.ws;
    if (IN(0)) { p0_prologue(C, a); if (BOTH(0)) xcd_barrier(bar); }
    if (IN(1)) {
        { pg8::Gemm g{(const bf16_t*)(dout + DO_XB), (const bf16_t*)(dout + DO_WINT), T, NIN, 1024}; pg8::StaticOrder S; S.init(T, NIN, C.G, (int)blockIdx.x);
          pg8::EpiProj E{(bf16_t*)(ws + WS_UPOOL), (bf16_t*)(ws + WS_Q), (bf16_t*)(ws + WS_K), (bf16_t*)(ws + WS_V), (bf16_t*)(ws + WS_G), (bf16_t*)(ws + WS_XQ), (bf16_t*)(ws + WS_GATES), (const float*)(dout + DO_CS)};
          pg8::gemm_phase<pg8::EpiProj, pg8::StaticOrder, true, true>(C.lds, g, S, E); }
        { pg8::Gemm g{(const bf16_t*)(dout + DO_MEMB), (const bf16_t*)(dout + DO_WMEMT), BATCH * MEML, 1024, 1024}; pg8::StaticOrder S; S.init(BATCH * MEML, 1024, C.G, (int)blockIdx.x);
          pg8::EpiMemKV E{(bf16_t*)(ws + WS_MEMK), (bf16_t*)(ws + WS_MEMV)};
          pg8::gemm_phase<pg8::EpiMemKV, pg8::StaticOrder, true, true>(C.lds, g, S, E); }
        if (BOTH(1)) xcd_barrier(bar);
    }
    if (IN(2)) {
        for (int s = C.vcu; s < T / 64; s += C.G) pooled_strip(C, (const bf16_t*)(ws + WS_UPOOL), (bf16_t*)(ws + WS_POOLED), s);
        for (int u = C.vcu; u < BATCH * NCH * 4; u += C.G) ret_state_unit(C, (const bf16_t*)(ws + WS_K), (const bf16_t*)(ws + WS_V), a.out, u);
        for (int u = C.vcu; u < BATCH * 4 * (SEQ / 256); u += C.G) xattn_unit(C, (bf16_t*)(ws + WS_XQ), (const bf16_t*)(ws + WS_MEMK), (const bf16_t*)(ws + WS_MEMV), u);
        if (BOTH(2)) xcd_barrier(bar);
    }
    if (IN(3)) {
        scan_all(C, a.out);
        pg8::Gemm g{(const bf16_t*)(ws + WS_POOLED), (const bf16_t*)(ws + WS_WPOOLBD), T, 512, 512}; pg8::StaticOrder S; S.init(T, 512, C.G, (int)blockIdx.x);
        pg8::EpiPoolMap E{(bf16_t*)(ws + WS_UPOOL), (const float*)a.in[5]};
        pg8::gemm_phase<pg8::EpiPoolMap, pg8::StaticOrder, true, true>(C.lds, g, S, E);
        if (BOTH(3)) xcd_barrier(bar);
    }
    if (IN(4)) {
        for (int u = C.vcu; u < BATCH * NCH * 4; u += C.G) ret_out_unit(C, (const bf16_t*)(ws + WS_Q), (const bf16_t*)(ws + WS_K), (const bf16_t*)(ws + WS_V), a.out, (bf16_t*)(ws + WS_G), (const float*)a.in[6], u);
        if (BOTH(4)) xcd_barrier(bar);
    }
    if (IN(5)) {
        const bf16_t* gates = (const bf16_t*)(ws + WS_GATES); bf16_t* merged = (bf16_t*)(ws + WS_MERGED);
        pg8::StaticOrder S; S.init(T, 1024, C.G, (int)blockIdx.x);
        { pg8::Gemm g{(const bf16_t*)(ws + WS_UPOOL), (const bf16_t*)(ws + WS_WPT), T, 1024, 512}; pg8::EpiGate<0> E{a.out, merged, gates, 0};
          pg8::gemm_phase<pg8::EpiGate<0>, pg8::StaticOrder, true, true>(C.lds, g, S, E); }
        __builtin_amdgcn_fence(__ATOMIC_ACQUIRE, "agent");
        { pg8::Gemm g{(const bf16_t*)(ws + WS_G), (const bf16_t*)(ws + WS_WRT), T, 1024, 1024}; pg8::EpiGate<1> E{a.out, merged, gates, 1024};
          pg8::gemm_phase<pg8::EpiGate<1>, pg8::StaticOrder, true, true>(C.lds, g, S, E); }
        __builtin_amdgcn_fence(__ATOMIC_ACQUIRE, "agent");
        { pg8::Gemm g{(const bf16_t*)(ws + WS_XQ), (const bf16_t*)(ws + WS_WXT), T, 1024, 512}; pg8::EpiGate<2> E{a.out, merged, gates, 2048};
          pg8::gemm_phase<pg8::EpiGate<2>, pg8::StaticOrder, true, true>(C.lds, g, S, E); }
        if (BOTH(5)) xcd_barrier(bar);
    }
    if (IN(6)) {
        pg8::Gemm g{(const bf16_t*)(ws + WS_MERGED), (const bf16_t*)(ws + WS_WOUTT), T, 1024, 1024}; pg8::StaticOrder S; S.init(T, 1024, C.G, (int)blockIdx.x);
        pg8::EpiResid E{a.out, (const float*)a.in[0]};
        pg8::gemm_phase<pg8::EpiResid, pg8::StaticOrder, true, true>(C.lds, g, S, E);
        if (BOTH(6)) xcd_barrier(bar);
    }
    if (IN(7)) {
        p5_ln1_router(C, a);
        if (BOTH(7) || (IN(7) && IN(8))) xcd_barrier(bar);
    }
    LAS int* mbase = (LAS int*)(C.lds + RING_BYTES);
    const int* cntp = (const int*)(ws + WS_CTL) + CW_CNT;
    if (IN(8)) {
        compute_base(C, cntp, mbase);
        pg8::MoeSched<true> S{mbase, cntp, (const int*)(ws + WS_LISTS), (const char*)(ws + WS_X1B), (const char*)(ws + WS_MOEW1), (size_t)512 * 1024 * 2, 1024, 2, C.G, (int)blockIdx.x};
        pg8::EpiMoeAct E{(bf16_t*)(ws + WS_ACT)};
        pg8::gemm_phase_g<pg8::EpiMoeAct, pg8::MoeSched<true>>(C.lds, 1024, S, E);
        if (BOTH(8)) xcd_barrier(bar);
    }
    if (IN(9)) {
        compute_base(C, cntp, mbase);
        pg8::Gemm g{(const bf16_t*)(ws + WS_ACT), (const bf16_t*)(ws + WS_MOEW2), 40960, 32 * 1024, 256}; pg8::MoeOrder S{mbase, 4, C.G, (int)blockIdx.x};
        pg8::EpiMoeY E{(bf16_t*)(ws + WS_Y)};
        pg8::gemm_phase<pg8::EpiMoeY, pg8::MoeOrder, true, true>(C.lds, g, S, E);
        if (BOTH(9)) xcd_barrier(bar);
    }
    if (IN(10)) {
        compute_base(C, cntp, mbase);
        p7_final(C, a, mbase);
    }
#undef IN
#undef BOTH
}

static int g_grid = 0;
static void launch_mega(hipStream_t stream, Args a, int lo, int hi, int li) {
    a.ph_lo = lo; a.ph_hi = hi; a.li = li; a.pad = 0;
    hipLaunchKernelGGL(mega, dim3(g_grid), dim3(NTHREADS), LDS_BYTES, stream, a);
    const hipError_t e = hipPeekAtLastError();
    if (e != hipSuccess) fprintf(stderr, "kernel_launch: launch failed: %s (grid %d)\n", hipGetErrorString(e), g_grid);
}

extern "C" void kernel_launch(void* const* d_in, const int* in_sizes, int n_in, void* d_out, int out_size, void* d_ws, size_t ws_size, hipStream_t stream) {
    if (g_grid == 0) {
        int dev = 0, cus = 0, per_cu = 0;
        (void)hipGetDevice(&dev); (void)hipDeviceGetAttribute(&cus, hipDeviceAttributeMultiprocessorCount, dev);
        (void)hipFuncSetAttribute((const void*)mega, hipFuncAttributeMaxDynamicSharedMemorySize, LDS_BYTES);
        (void)hipOccupancyMaxActiveBlocksPerMultiprocessor(&per_cu, (const void*)mega, NTHREADS, LDS_BYTES);
        if (per_cu < 1) { fprintf(stderr, "kernel_launch: occupancy query reports %d blocks per CU\n", per_cu); per_cu = 1; }
        g_grid = cus;
    }
    Args a{}; for (int i = 0; i < 23; ++i) a.in[i] = d_in[i]; a.out = (float*)d_out; a.ws = (unsigned char*)d_ws;
    (void)hipMemsetAsync((unsigned char*)d_ws + WS_CTL, 0, 1 * MiB, stream);
    launch_mega(stream, a, 0, 11, 0);
}
```

```cpp
#include <hip/hip_runtime.h>
#include <stdint.h>
#include <math.h>
#include <cstdio>

typedef unsigned short bf16_t;
__device__ __forceinline__ float bf2f(bf16_t h) { return __uint_as_float(((unsigned)h) << 16); }
__device__ __forceinline__ bf16_t f2bf(float f) { unsigned u = __float_as_uint(f); return (bf16_t)((u + 0x7fffu + ((u >> 16) & 1u)) >> 16); }

constexpr int D = 1024, BATCH = 4, SEQ = 4096, T = BATCH * SEQ, MEML = 256;
constexpr int NIN = 7168;
constexpr int CH = 128, NCH = SEQ / CH;
constexpr int NEXP = 32, DEXP = 256;
constexpr float LN_EPS = 1e-5f;
constexpr float ALPHA = 1.189207115002721f;
constexpr size_t MiB = 1u << 20;
constexpr size_t WS_CTL = 0, WS_TOKINFO = 1 * MiB, WS_LISTS = 2 * MiB;
constexpr size_t WS_WPT = 4 * MiB, WS_WRT = 5 * MiB, WS_WXT = 7 * MiB, WS_WOUTT = 8 * MiB, WS_WPOOLBD = 10 * MiB;
constexpr size_t WS_MEMK = 11 * MiB, WS_MEMV = 12 * MiB, WS_POOLED = 13 * MiB;
constexpr size_t WS_UPOOL = 32 * MiB, WS_Q = 48 * MiB, WS_K = 64 * MiB, WS_V = 80 * MiB, WS_G = 112 * MiB, WS_XQ = 144 * MiB, WS_GATES = 160 * MiB;
constexpr size_t WS_MERGED = 48 * MiB, WS_X1B = 80 * MiB, WS_ACT = 32 * MiB, WS_TMP = 52 * MiB, WS_Y = 176 * MiB;
constexpr size_t WS_MOEW1 = 112 * MiB, WS_MOEW2 = 144 * MiB;
constexpr size_t DO_XB = 0, DO_WINT = 32 * MiB, DO_CS = 50 * MiB;
constexpr size_t WS_MEMB = 1 * MiB, WS_WMEMT = 29 * MiB;
constexpr int CW_CNT = 1024;
constexpr int CW_BASE = 1088;
constexpr int CW_BAR = 4096;
#ifndef PHASE_REP
#define PHASE_REP -1
#endif
#define REP(k) for (int rep_ = 0; rep_ < ((PHASE_REP) == (k) ? 2 : 1); ++rep_)

namespace pg8 {
#define PG8_LAS __attribute__((address_space(3)))
typedef unsigned short bf16_t;
typedef short bf16x8 __attribute__((ext_vector_type(8)));
typedef float f32x4 __attribute__((ext_vector_type(4)));
typedef unsigned u32x4 __attribute__((ext_vector_type(4)));
constexpr int BM = 256, BK = 64, HALF = 128, HTB = HALF * BK * 2  , STAGE_BYTES = 8 * HTB, NXCD = 8, WGM = 8;

__host__ __device__ __forceinline__ int lds_byte(int r, int c) { const int st = (r >> 4) * 2 + (c >> 5), rr = r & 15, cc = c & 31, ob = rr * 64 + cc * 2; return st * 1024 + (ob ^ (((ob >> 9) & 1) << 5)); }
__host__ __device__ __forceinline__ void stage_rc(int b, int& R, int& C) { const int st = b / 1024, sb = b % 1024, swz = sb ^ (((sb >> 9) & 1) << 5); R = (st >> 1) * 16 + swz / 64; C = (st & 1) * 32 + (swz % 64) / 2; }
__host__ __device__ __forceinline__ int perm32(int rho) { const int n = rho >> 4, i = rho & 15; return 8 * (i >> 2) + 4 * n + (i & 3); }

struct Unit { int pm, pn; };
struct Gemm { const bf16_t* A; const bf16_t* Bt; int M, N, K; };

struct StaticOrder {
    int nM, nN, nwg, G, c;
    __host__ __device__ void init(int M, int N, int G_, int c_) { nM = M / BM; nN = N / BM; nwg = nM * nN; G = G_; c = c_; }
    __host__ __device__ bool next(int i, Unit& u) const {
        const long L = (long)i * G + c; if (L >= nwg) return false;
        int wgid = (int)L; { const int q = nwg / NXCD, r = nwg % NXCD, xcd = wgid % NXCD, off = wgid / NXCD; wgid = (xcd < r ? xcd * (q + 1) : r * (q + 1) + (xcd - r) * q) + off; }
        const int nig = WGM * nN, gid = wgid / nig, fm = gid * WGM, gsz = (nM - fm) < WGM ? (nM - fm) : WGM;
        u.pm = fm + ((wgid % nig) % gsz); u.pn = (wgid % nig) / gsz; return true;
    }
    __device__ __forceinline__ void a_ready(const Unit&) const {}
    __device__ __forceinline__ void done(const Unit&) const {}
};


template <class Epi, class Sched, bool ALIGN_EPI = false, bool SP2 = false>
__device__ __forceinline__ void gemm_phase(PG8_LAS unsigned char* lds, const Gemm g, const Sched& S, const Epi& E) {
    const int tid = threadIdx.x, wid = __builtin_amdgcn_readfirstlane(tid >> 6), lane = tid & 63, wr = wid >> 2, wc = wid & 3, fr = lane & 15, fq = lane >> 4;
    const int K = g.K, nt = K / BK;
    unsigned voffA[2], voffB[2];
#pragma unroll
    for (int i = 0; i < 2; ++i) { int R, C; stage_rc(tid * 16 + i * 8192, R, C); const int Rb = Epi::PERM ? ((R & ~31) + perm32(R & 31)) : R;
        voffA[i] = (unsigned)(R * K + C) * 2u; voffB[i] = (unsigned)(Rb * K + C) * 2u; }
    const size_t kstep = (size_t)(BK * 2);
    const size_t hstep = (size_t)HALF * K * 2;
    const size_t tstep = 2 * hstep;
    const unsigned ldsw = (unsigned)wid * 1024u;
    const int aoff = lds_byte(wr * 64 + fr, fq * 8), boff = lds_byte(wc * 32 + fr, fq * 8);
#define PG8_SA(b, h) (((b) * 2 + (h)) * HTB)
#define PG8_SB(b, h) ((4 + (b) * 2 + (h)) * HTB)
#define PG8_STAGE(bufoff, gbase, voff) do { _Pragma("unroll") for (int _i = 0; _i < 2; ++_i) \
        __builtin_amdgcn_global_load_lds((const unsigned*)((const char*)(gbase) + (voff)[_i]), (PG8_LAS unsigned*)(lds + (bufoff) + ldsw + _i * 8192), 16, 0, 0); } while (0)
#define PG8_LDA(dst, b, h) do { _Pragma("unroll") for (int m = 0; m < 4; ++m) _Pragma("unroll") for (int k = 0; k < 2; ++k) dst[m][k] = *(const PG8_LAS bf16x8*)(lds + PG8_SA(b, h) + aoff + m * 2048 + k * 1024); } while (0)
#define PG8_LDB(dst, b, h) do { _Pragma("unroll") for (int n = 0; n < 2; ++n) _Pragma("unroll") for (int k = 0; k < 2; ++k) dst[n][k] = *(const PG8_LAS bf16x8*)(lds + PG8_SB(b, h) + boff + n * 2048 + k * 1024); } while (0)
#define PG8_MMA(ai, bj, At, Bt) do { __builtin_amdgcn_s_setprio(1); _Pragma("unroll") for (int m = 0; m < 4; ++m) _Pragma("unroll") for (int n = 0; n < 2; ++n) _Pragma("unroll") for (int k = 0; k < 2; ++k) \
        acc[ai][bj][m][n] = __builtin_amdgcn_mfma_f32_16x16x32_bf16(Bt[n][k], At[m][k], acc[ai][bj][m][n], 0, 0, 0); __builtin_amdgcn_s_setprio(0); } while (0)
#define PG8_WAIT_V(n) asm volatile("s_waitcnt vmcnt(" #n ")" ::: "memory")
#define PG8_WAIT_L(n) asm volatile("s_waitcnt lgkmcnt(" #n ")" ::: "memory")
#define PG8_BAR __builtin_amdgcn_s_barrier()
#define PG8_SCHED __builtin_amdgcn_sched_barrier(0)
    Unit cur, nxt; int ui = 0;
    if (!S.next(0, cur)) return;
    f32x4 acc[2][2][4][2];
#pragma unroll
    for (int a = 0; a < 2; ++a)
#pragma unroll
        for (int b = 0; b < 2; ++b)
#pragma unroll
            for (int m = 0; m < 4; ++m)
#pragma unroll
                for (int n = 0; n < 2; ++n) acc[a][b][m][n] = (f32x4){0.f, 0.f, 0.f, 0.f};
    bf16x8 At[4][2], B0[2][2], B1[2][2];
    const char* cA = (const char*)g.A + (size_t)cur.pm * tstep; const char* cB = (const char*)g.Bt + (size_t)cur.pn * tstep;
    S.a_ready(cur);
    if constexpr (SP2) {
        PG8_STAGE(PG8_SB(0, 0), cB, voffB); PG8_STAGE(PG8_SB(0, 1), cB + hstep, voffB); PG8_STAGE(PG8_SA(0, 0), cA, voffA); PG8_STAGE(PG8_SA(0, 1), cA + hstep, voffA);
        if (wr == 1) PG8_BAR;
        PG8_WAIT_V(2); PG8_BAR;
        PG8_STAGE(PG8_SB(1, 0), cB + kstep, voffB); PG8_STAGE(PG8_SA(1, 0), cA + kstep, voffA); PG8_STAGE(PG8_SB(1, 1), cB + hstep + kstep, voffB);
        PG8_WAIT_V(6); PG8_BAR;
    } else {
        PG8_STAGE(PG8_SB(0, 0), cB, voffB); PG8_STAGE(PG8_SA(0, 0), cA, voffA); PG8_STAGE(PG8_SB(0, 1), cB + hstep, voffB); PG8_STAGE(PG8_SA(0, 1), cA + hstep, voffA);
        if (wr == 1) PG8_BAR;
        PG8_WAIT_V(4); PG8_BAR;
        PG8_STAGE(PG8_SB(1, 0), cB + kstep, voffB); PG8_STAGE(PG8_SA(1, 0), cA + kstep, voffA); PG8_STAGE(PG8_SB(1, 1), cB + hstep + kstep, voffB);
        PG8_WAIT_V(6); PG8_BAR;
    }
    for (;;) {
        const bool has_next = S.next(ui + 1, nxt);
        const char* nA = has_next ? (const char*)g.A + (size_t)nxt.pm * tstep : cA; const char* nB = has_next ? (const char*)g.Bt + (size_t)nxt.pn * tstep : cB;
#pragma unroll 1
        for (int t = 0; t < nt; t += 2) {
            const bool last = (t == nt - 2);
            const char* a1 = cA + (size_t)(t + 1) * kstep;
            const char* a2 = last ? nA : cA + (size_t)(t + 2) * kstep; const char* b2 = last ? nB : cB + (size_t)(t + 2) * kstep;
            const char* a3 = a2 + kstep; const char* b3 = b2 + kstep;
            if (last && has_next) S.a_ready(nxt);
            if constexpr (SP2) {
            PG8_LDB(B0, 0, 0); PG8_LDB(B1, 0, 1); PG8_SCHED; PG8_LDA(At, 0, 0); PG8_STAGE(PG8_SA(1, 1), a1 + hstep, voffA);
            PG8_WAIT_V(8); PG8_WAIT_L(0); PG8_BAR; PG8_MMA(0, 0, At, B0); PG8_MMA(0, 1, At, B1); PG8_BAR; PG8_SCHED;
            PG8_LDA(At, 0, 1); PG8_STAGE(PG8_SB(0, 0), b2, voffB); PG8_STAGE(PG8_SB(0, 1), b2 + hstep, voffB); PG8_STAGE(PG8_SA(0, 0), a2, voffA);
            PG8_WAIT_V(8); PG8_WAIT_L(0); PG8_BAR; PG8_MMA(1, 0, At, B0); PG8_MMA(1, 1, At, B1); PG8_BAR; PG8_SCHED;
            PG8_LDB(B0, 1, 0); PG8_LDB(B1, 1, 1); PG8_SCHED; PG8_LDA(At, 1, 0); PG8_STAGE(PG8_SA(0, 1), a2 + hstep, voffA);
            PG8_WAIT_V(8); PG8_WAIT_L(0); PG8_BAR; PG8_MMA(0, 0, At, B0); PG8_MMA(0, 1, At, B1); PG8_BAR; PG8_SCHED;
            PG8_LDA(At, 1, 1); PG8_STAGE(PG8_SB(1, 0), b3, voffB); PG8_STAGE(PG8_SB(1, 1), b3 + hstep, voffB); PG8_STAGE(PG8_SA(1, 0), a3, voffA);
            PG8_WAIT_V(8); PG8_WAIT_L(0); PG8_BAR; PG8_MMA(1, 0, At, B0); PG8_MMA(1, 1, At, B1); PG8_BAR; PG8_SCHED;
            } else {
            PG8_LDB(B0, 0, 0); PG8_SCHED; PG8_LDA(At, 0, 0); PG8_STAGE(PG8_SA(1, 1), a1 + hstep, voffA);
            PG8_WAIT_L(8); PG8_BAR; PG8_WAIT_L(0); PG8_MMA(0, 0, At, B0); PG8_BAR; PG8_SCHED;
            PG8_LDB(B1, 0, 1); PG8_STAGE(PG8_SB(0, 0), b2, voffB);
            PG8_BAR; PG8_WAIT_L(0); PG8_MMA(0, 1, At, B1); PG8_BAR;
            PG8_LDA(At, 0, 1); PG8_STAGE(PG8_SA(0, 0), a2, voffA);
            PG8_BAR; PG8_WAIT_L(0); PG8_MMA(1, 0, At, B0); PG8_BAR; PG8_SCHED;
            PG8_STAGE(PG8_SB(0, 1), b2 + hstep, voffB);
            PG8_WAIT_V(6); PG8_BAR; PG8_MMA(1, 1, At, B1); PG8_BAR;
            PG8_LDB(B0, 1, 0); PG8_SCHED; PG8_LDA(At, 1, 0); PG8_STAGE(PG8_SA(0, 1), a2 + hstep, voffA);
            PG8_WAIT_L(8); PG8_BAR; PG8_WAIT_L(0); PG8_MMA(0, 0, At, B0); PG8_BAR; PG8_SCHED;
            PG8_LDB(B1, 1, 1); PG8_STAGE(PG8_SB(1, 0), b3, voffB);
            PG8_BAR; PG8_WAIT_L(0); PG8_MMA(0, 1, At, B1); PG8_BAR;
            PG8_LDA(At, 1, 1); PG8_STAGE(PG8_SA(1, 0), a3, voffA);
            PG8_BAR; PG8_WAIT_L(0); PG8_MMA(1, 0, At, B0); PG8_BAR; PG8_SCHED;
            PG8_STAGE(PG8_SB(1, 1), b3 + hstep, voffB);
            PG8_WAIT_V(6); PG8_BAR; PG8_MMA(1, 1, At, B1); PG8_BAR;
            }
        }
        if constexpr (ALIGN_EPI) { if (wr == 0) PG8_BAR; }
        if constexpr (!Epi::AFTER_DRAIN) { E(acc, cur, wr, wc, fr, fq); S.done(cur); }
        if (!has_next) break;
#pragma unroll
        for (int a = 0; a < 2; ++a)
#pragma unroll
            for (int b = 0; b < 2; ++b)
#pragma unroll
                for (int m = 0; m < 4; ++m)
#pragma unroll
                    for (int n = 0; n < 2; ++n) acc[a][b][m][n] = (f32x4){0.f, 0.f, 0.f, 0.f};
        cur = nxt; cA = nA; cB = nB; ++ui;
        if constexpr (ALIGN_EPI) { if (wr == 1) PG8_BAR; }
    }
    PG8_WAIT_V(0);
    if constexpr (!ALIGN_EPI) { if (wr == 0) PG8_BAR; }
    PG8_BAR;
    if constexpr (Epi::AFTER_DRAIN) { E.fused(acc, cur, wr, wc, fr, fq, lds, wid, lane); S.done(cur); }
#undef PG8_SA
#undef PG8_SB
#undef PG8_STAGE
#undef PG8_LDA
#undef PG8_LDB
#undef PG8_MMA
#undef PG8_WAIT_V
#undef PG8_WAIT_L
#undef PG8_BAR
#undef PG8_SCHED
}
}

namespace pg8 {
struct UnitG : Unit { int e; };
template <class Epi, class Sched>
__device__ __forceinline__ void gemm_phase_g(PG8_LAS unsigned char* lds, const int K, const Sched& S, const Epi& E) {
    const int tid = threadIdx.x, wid = __builtin_amdgcn_readfirstlane(tid >> 6), lane = tid & 63, wr = wid >> 2, wc = wid & 3, fr = lane & 15, fq = lane >> 4;
    const int nt = K / BK;
    unsigned voffB[2];
#pragma unroll
    for (int i = 0; i < 2; ++i) { int R, C; stage_rc(tid * 16 + i * 8192, R, C); const int Rb = Epi::PERM ? ((R & ~31) + perm32(R & 31)) : R;
        voffB[i] = (unsigned)(Rb * K + C) * 2u; }
    const size_t kstep = (size_t)(BK * 2);
    const size_t hstep = (size_t)HALF * K * 2;
    const unsigned ldsw = (unsigned)wid * 1024u;
    const int aoff = lds_byte(wr * 64 + fr, fq * 8), boff = lds_byte(wc * 32 + fr, fq * 8);
#define PG8_SA(b, h) (((b) * 2 + (h)) * HTB)
#define PG8_SB(b, h) ((4 + (b) * 2 + (h)) * HTB)
#define PG8_STAGE(bufoff, gbase, voff) do { _Pragma("unroll") for (int _i = 0; _i < 2; ++_i) \
        __builtin_amdgcn_global_load_lds((const unsigned*)((const char*)(gbase) + (voff)[_i]), (PG8_LAS unsigned*)(lds + (bufoff) + ldsw + _i * 8192), 16, 0, 0); } while (0)
#define PG8_LDA(dst, b, h) do { _Pragma("unroll") for (int m = 0; m < 4; ++m) _Pragma("unroll") for (int k = 0; k < 2; ++k) dst[m][k] = *(const PG8_LAS bf16x8*)(lds + PG8_SA(b, h) + aoff + m * 2048 + k * 1024); } while (0)
#define PG8_LDB(dst, b, h) do { _Pragma("unroll") for (int n = 0; n < 2; ++n) _Pragma("unroll") for (int k = 0; k < 2; ++k) dst[n][k] = *(const PG8_LAS bf16x8*)(lds + PG8_SB(b, h) + boff + n * 2048 + k * 1024); } while (0)
#define PG8_MMA(ai, bj, At, Bt) do { __builtin_amdgcn_s_setprio(1); _Pragma("unroll") for (int m = 0; m < 4; ++m) _Pragma("unroll") for (int n = 0; n < 2; ++n) _Pragma("unroll") for (int k = 0; k < 2; ++k) \
        acc[ai][bj][m][n] = __builtin_amdgcn_mfma_f32_16x16x32_bf16(Bt[n][k], At[m][k], acc[ai][bj][m][n], 0, 0, 0); __builtin_amdgcn_s_setprio(0); } while (0)
#define PG8_WAIT_V(n) asm volatile("s_waitcnt vmcnt(" #n ")" ::: "memory")
#define PG8_WAIT_L(n) asm volatile("s_waitcnt lgkmcnt(" #n ")" ::: "memory")
#define PG8_BAR __builtin_amdgcn_s_barrier()
#define PG8_SCHED __builtin_amdgcn_sched_barrier(0)
    UnitG cur, nxt; int ui = 0;
    if (!S.next(0, cur)) return;
    f32x4 acc[2][2][4][2];
#pragma unroll
    for (int a = 0; a < 2; ++a)
#pragma unroll
        for (int b = 0; b < 2; ++b)
#pragma unroll
            for (int m = 0; m < 4; ++m)
#pragma unroll
                for (int n = 0; n < 2; ++n) acc[a][b][m][n] = (f32x4){0.f, 0.f, 0.f, 0.f};
    bf16x8 At[4][2], B0[2][2], B1[2][2];
    const char* cA = S.a_base(cur); const char* cB = S.b_base(cur);
    unsigned vA0[2], vA1[2];
#pragma unroll
    for (int i = 0; i < 2; ++i) { int R, C; stage_rc(tid * 16 + i * 8192, R, C); vA0[i] = S.a_voff(cur, R, C, 0); vA1[i] = S.a_voff(cur, R, C, 1); }
    PG8_STAGE(PG8_SB(0, 0), cB, voffB); PG8_STAGE(PG8_SB(0, 1), cB + hstep, voffB); PG8_STAGE(PG8_SA(0, 0), cA, vA0); PG8_STAGE(PG8_SA(0, 1), cA, vA1);
    if (wr == 1) PG8_BAR;
    PG8_WAIT_V(2); PG8_BAR;
    PG8_STAGE(PG8_SB(1, 0), cB + kstep, voffB); PG8_STAGE(PG8_SA(1, 0), cA + kstep, vA0); PG8_STAGE(PG8_SB(1, 1), cB + hstep + kstep, voffB);
    PG8_WAIT_V(6); PG8_BAR;
    for (;;) {
        const bool has_next = S.next(ui + 1, nxt);
        const char* nA = has_next ? S.a_base(nxt) : cA; const char* nB = has_next ? S.b_base(nxt) : cB;
#pragma unroll 1
        for (int t = 0; t < nt; t += 2) {
            const bool last = (t == nt - 2);
            const char* a1 = cA + (size_t)(t + 1) * kstep;
            const char* a2 = last ? nA : cA + (size_t)(t + 2) * kstep; const char* b2 = last ? nB : cB + (size_t)(t + 2) * kstep;
            const char* a3 = a2 + kstep; const char* b3 = b2 + kstep;
            unsigned sA0[2], sA1[2];
#pragma unroll
            for (int i = 0; i < 2; ++i) { sA0[i] = vA0[i]; sA1[i] = vA1[i]; }
            if (last && has_next) {
#pragma unroll
                for (int i = 0; i < 2; ++i) { int R, C; stage_rc(tid * 16 + i * 8192, R, C); sA0[i] = S.a_voff(nxt, R, C, 0); sA1[i] = S.a_voff(nxt, R, C, 1); }
            }
            PG8_LDB(B0, 0, 0); PG8_LDB(B1, 0, 1); PG8_SCHED; PG8_LDA(At, 0, 0); PG8_STAGE(PG8_SA(1, 1), a1, vA1);
            PG8_WAIT_V(8); PG8_WAIT_L(0); PG8_BAR; PG8_MMA(0, 0, At, B0); PG8_MMA(0, 1, At, B1); PG8_BAR; PG8_SCHED;
            PG8_LDA(At, 0, 1); PG8_STAGE(PG8_SB(0, 0), b2, voffB); PG8_STAGE(PG8_SB(0, 1), b2 + hstep, voffB); PG8_STAGE(PG8_SA(0, 0), a2, sA0);
            PG8_WAIT_V(8); PG8_WAIT_L(0); PG8_BAR; PG8_MMA(1, 0, At, B0); PG8_MMA(1, 1, At, B1); PG8_BAR; PG8_SCHED;
            PG8_LDB(B0, 1, 0); PG8_LDB(B1, 1, 1); PG8_SCHED; PG8_LDA(At, 1, 0); PG8_STAGE(PG8_SA(0, 1), a2, sA1);
            PG8_WAIT_V(8); PG8_WAIT_L(0); PG8_BAR; PG8_MMA(0, 0, At, B0); PG8_MMA(0, 1, At, B1); PG8_BAR; PG8_SCHED;
            PG8_LDA(At, 1, 1); PG8_STAGE(PG8_SB(1, 0), b3, voffB); PG8_STAGE(PG8_SB(1, 1), b3 + hstep, voffB); PG8_STAGE(PG8_SA(1, 0), a3, sA0);
            PG8_WAIT_V(8); PG8_WAIT_L(0); PG8_BAR; PG8_MMA(1, 0, At, B0); PG8_MMA(1, 1, At, B1); PG8_BAR; PG8_SCHED;
        }
        if (wr == 0) PG8_BAR;
        E(acc, cur, wr, wc, fr, fq);
        if (!has_next) break;
#pragma unroll
        for (int a = 0; a < 2; ++a)
#pragma unroll
            for (int b = 0; b < 2; ++b)
#pragma unroll
                for (int m = 0; m < 4; ++m)
#pragma unroll
                    for (int n = 0; n < 2; ++n) acc[a][b][m][n] = (f32x4){0.f, 0.f, 0.f, 0.f};
        cur = nxt; cA = nA; cB = nB; ++ui;
#pragma unroll
        for (int i = 0; i < 2; ++i) { int R, C; stage_rc(tid * 16 + i * 8192, R, C); vA0[i] = S.a_voff(cur, R, C, 0); vA1[i] = S.a_voff(cur, R, C, 1); }
        if (wr == 1) PG8_BAR;
    }
    PG8_WAIT_V(0);
    PG8_BAR;
#undef PG8_SA
#undef PG8_SB
#undef PG8_STAGE
#undef PG8_LDA
#undef PG8_LDB
#undef PG8_MMA
#undef PG8_WAIT_V
#undef PG8_WAIT_L
#undef PG8_BAR
#undef PG8_SCHED
}
}

namespace pg8 {
typedef unsigned u32x2 __attribute__((ext_vector_type(2)));
typedef __bf16 bf16x2_t __attribute__((ext_vector_type(2)));
typedef float f32x2_t __attribute__((ext_vector_type(2)));
__device__ __forceinline__ unsigned cvt_pk_bf16(float lo, float hi) { f32x2_t v = {lo, hi}; bf16x2_t r = __builtin_convertvector(v, bf16x2_t); return __builtin_bit_cast(unsigned, r); }
__device__ __forceinline__ float fast_sigmoid(float x) { return __builtin_amdgcn_rcpf(1.f + __builtin_amdgcn_exp2f(-1.4426950408889634f * x)); }
__device__ __forceinline__ void store8(bf16_t* p, const f32x4& v0, const f32x4& v1) {
    u32x4 w; w.x = cvt_pk_bf16(v0[0], v0[1]); w.y = cvt_pk_bf16(v0[2], v0[3]); w.z = cvt_pk_bf16(v1[0], v1[1]); w.w = cvt_pk_bf16(v1[2], v1[3]); *(u32x4*)p = w;
}
__device__ __forceinline__ float log2_gamma(int h) { return h == 0 ? -0.045803689613124944f : (h == 1 ? -0.022720076500083580f : (h == 2 ? -0.011315313227834146f : -0.005646563141142063f)); }

struct EpiProj {
    static constexpr bool PERM = true, AFTER_DRAIN = false;
    bf16_t *upool, *q, *k, *v, *g, *xq, *gates; const float* cs;
    template <int KIND>
    __device__ __forceinline__ void run(const f32x4 (&acc)[2][2][4][2], bf16_t* base, int ld, int colt, int pm, int hbase, int wr, int wc, int fr, int fq) const {
        const int row0 = pm * BM + wr * 64 + fr, lc = wc * 32 + 8 * fq;
#pragma unroll
        for (int ai = 0; ai < 2; ++ai)
#pragma unroll
            for (int m = 0; m < 4; ++m) {
                const int row = row0 + ai * HALF + m * 16;
                bf16_t* rowp = base + (size_t)row * ld + colt + lc;
                f32x4 c0, c1;
                if (KIND >= 4) { const f32x4* cp = (const f32x4*)(cs + ((size_t)row * 64 + (lc >> 1)) * 2); c0 = cp[0]; c1 = cp[1]; }
#pragma unroll
                for (int bj = 0; bj < 2; ++bj) {
                    f32x4 v0 = acc[ai][bj][m][0], v1 = acc[ai][bj][m][1];
                    if (KIND == 1) { for (int e = 0; e < 4; ++e) { v0[e] = v0[e] * fast_sigmoid(v0[e]); v1[e] = v1[e] * fast_sigmoid(v1[e]); } }
                    else if (KIND == 2) { v0 = v0 * 0.08838834764831845f; v1 = v1 * 0.08838834764831845f; }
                    else if (KIND == 3) { for (int e = 0; e < 4; ++e) { v0[e] = fast_sigmoid(v0[e]); v1[e] = fast_sigmoid(v1[e]); } }
                    else if (KIND >= 4) {
                        const float cpos = (float)(row & (CH - 1)), l2g = log2_gamma(hbase + bj);
                        const float sc = (KIND == 4) ? __builtin_amdgcn_exp2f(cpos * l2g) : 0.08838834764831845f * __builtin_amdgcn_exp2f(-cpos * l2g);
                        f32x4 r0, r1;
                        r0[0] = (v0[0] * c0[0] - v0[1] * c0[1]) * sc; r0[1] = (v0[1] * c0[0] + v0[0] * c0[1]) * sc;
                        r0[2] = (v0[2] * c0[2] - v0[3] * c0[3]) * sc; r0[3] = (v0[3] * c0[2] + v0[2] * c0[3]) * sc;
                        r1[0] = (v1[0] * c1[0] - v1[1] * c1[1]) * sc; r1[1] = (v1[1] * c1[0] + v1[0] * c1[1]) * sc;
                        r1[2] = (v1[2] * c1[2] - v1[3] * c1[3]) * sc; r1[3] = (v1[3] * c1[2] + v1[2] * c1[3]) * sc;
                        v0 = r0; v1 = r1;
                    }
                    store8(rowp + bj * HALF, v0, v1);
                }
            }
    }
    __device__ __forceinline__ void operator()(const f32x4 (&acc)[2][2][4][2], const Unit& u, int wr, int wc, int fr, int fq) const {
        const int pn = u.pn;
        if (pn < 2) run<0>(acc, upool, 512, pn * 256, u.pm, 0, wr, wc, fr, fq);
        else if (pn < 4) run<4>(acc, q, 512, (pn - 2) * 256, u.pm, (pn - 2) * 2, wr, wc, fr, fq);
        else if (pn < 6) run<5>(acc, k, 512, (pn - 4) * 256, u.pm, (pn - 4) * 2, wr, wc, fr, fq);
        else if (pn < 10) run<0>(acc, v, 1024, (pn - 6) * 256, u.pm, 0, wr, wc, fr, fq);
        else if (pn < 14) run<1>(acc, g, 1024, (pn - 10) * 256, u.pm, 0, wr, wc, fr, fq);
        else if (pn < 16) run<2>(acc, xq, 512, (pn - 14) * 256, u.pm, 0, wr, wc, fr, fq);
        else run<3>(acc, gates, 3072, (pn - 16) * 256, u.pm, 0, wr, wc, fr, fq);
    }
};
}

namespace pg8 {
struct EpiMemKV {
    static constexpr bool PERM = true, AFTER_DRAIN = false;
    bf16_t *mk, *mv;
    __device__ __forceinline__ void operator()(const f32x4 (&acc)[2][2][4][2], const Unit& u, int wr, int wc, int fr, int fq) const {
        bf16_t* base = u.pn < 2 ? mk : mv; const int colt = (u.pn & 1) * 256;
        const int row0 = u.pm * BM + wr * 64 + fr, lc = wc * 32 + 8 * fq;
#pragma unroll
        for (int ai = 0; ai < 2; ++ai)
#pragma unroll
            for (int m = 0; m < 4; ++m) { bf16_t* rowp = base + (size_t)(row0 + ai * HALF + m * 16) * 512 + colt + lc;
#pragma unroll
                for (int bj = 0; bj < 2; ++bj) store8(rowp + bj * HALF, acc[ai][bj][m][0], acc[ai][bj][m][1]); }
    }
};
struct EpiPoolMap {
    static constexpr bool PERM = true, AFTER_DRAIN = false;
    bf16_t* ypool; const float* scale;
    __device__ __forceinline__ void operator()(const f32x4 (&acc)[2][2][4][2], const Unit& u, int wr, int wc, int fr, int fq) const {
        const int row0 = u.pm * BM + wr * 64 + fr, col0 = u.pn * 256 + wc * 32 + 8 * fq;
        f32x4 s[2][2];
#pragma unroll
        for (int bj = 0; bj < 2; ++bj) { s[bj][0] = *(const f32x4*)(scale + col0 + bj * HALF); s[bj][1] = *(const f32x4*)(scale + col0 + bj * HALF + 4); }
#pragma unroll
        for (int ai = 0; ai < 2; ++ai)
#pragma unroll
            for (int m = 0; m < 4; ++m) { bf16_t* rowp = ypool + (size_t)(row0 + ai * HALF + m * 16) * 512 + col0;
#pragma unroll
                for (int bj = 0; bj < 2; ++bj) store8(rowp + bj * HALF, acc[ai][bj][m][0] * s[bj][0], acc[ai][bj][m][1] * s[bj][1]); }
    }
};
__device__ __forceinline__ f32x4 bf4_to_f32(unsigned lo, unsigned hi) {
    f32x4 r; r[0] = __uint_as_float(lo << 16); r[1] = __uint_as_float(lo & 0xffff0000u); r[2] = __uint_as_float(hi << 16); r[3] = __uint_as_float(hi & 0xffff0000u); return r;
}
template <int MODE> struct EpiGate {
    static constexpr bool PERM = true, AFTER_DRAIN = false;
    float* accf; bf16_t* merged; const bf16_t* gates; int gofs;
    __device__ __forceinline__ void operator()(const f32x4 (&acc)[2][2][4][2], const Unit& u, int wr, int wc, int fr, int fq) const {
        const int row0 = u.pm * BM + wr * 64 + fr, col0 = u.pn * 256 + wc * 32 + 8 * fq;
#pragma unroll
        for (int ai = 0; ai < 2; ++ai)
#pragma unroll
            for (int m = 0; m < 4; ++m) { const size_t row = (size_t)(row0 + ai * HALF + m * 16);
#pragma unroll
                for (int bj = 0; bj < 2; ++bj) { const int c = col0 + bj * HALF;
                    const u32x4 gw = *(const u32x4*)(gates + row * 3072 + gofs + c);
                    f32x4 v0 = acc[ai][bj][m][0] * bf4_to_f32(gw.x, gw.y), v1 = acc[ai][bj][m][1] * bf4_to_f32(gw.z, gw.w);
                    float* ap = accf + row * 1024 + c;
                    if (MODE >= 1) { v0 += *(const f32x4*)ap; v1 += *(const f32x4*)(ap + 4); }
                    if (MODE <= 1) { *(f32x4*)ap = v0; *(f32x4*)(ap + 4) = v1; } else store8(merged + row * 1024 + c, v0, v1); }
                asm volatile("" ::: "memory"); }
    }
};
struct EpiResid {
    static constexpr bool PERM = true, AFTER_DRAIN = false;
    float* h; const float* x;
    __device__ __forceinline__ void operator()(const f32x4 (&acc)[2][2][4][2], const Unit& u, int wr, int wc, int fr, int fq) const {
        const int row0 = u.pm * BM + wr * 64 + fr, col0 = u.pn * 256 + wc * 32 + 8 * fq;
#pragma unroll
        for (int ai = 0; ai < 2; ++ai)
#pragma unroll
            for (int m = 0; m < 4; ++m) { const size_t o = (size_t)(row0 + ai * HALF + m * 16) * 1024 + col0;
#pragma unroll
                for (int bj = 0; bj < 2; ++bj) { const float* xp = x + o + bj * HALF; float* hp = h + o + bj * HALF;
                    *(f32x4*)hp = *(const f32x4*)xp * ALPHA + acc[ai][bj][m][0]; *(f32x4*)(hp + 4) = *(const f32x4*)(xp + 4) * ALPHA + acc[ai][bj][m][1]; }
                asm volatile("" ::: "memory"); }
    }
};
}

#define GAS __attribute__((address_space(1)))
#define LAS __attribute__((address_space(3)))
typedef unsigned v4u __attribute__((ext_vector_type(4)));
typedef unsigned v2u __attribute__((ext_vector_type(2)));
typedef float f32x4 __attribute__((ext_vector_type(4)));
typedef float f32x16 __attribute__((ext_vector_type(16)));
typedef short bf16x8 __attribute__((ext_vector_type(8)));
typedef short bf16x4 __attribute__((ext_vector_type(4)));
#define LDS_WAIT() asm volatile("s_waitcnt lgkmcnt(0)" ::: "memory")
#define VM_WAIT() asm volatile("s_waitcnt vmcnt(0)" ::: "memory")
__device__ __forceinline__ unsigned pk2(float lo, float hi) { return pg8::cvt_pk_bf16(lo, hi); }
constexpr int NWAVES = 8, NTHREADS = 512;
constexpr int RING_BYTES = 131072;
constexpr int MISC_OFF = 163840 - 256;
constexpr int LDS_BYTES = 163840;

#define XB_TMO      128
#define XB_XCNT(j)  (256  + 64 * (j))
#define XB_XSUB(j)  (1280 + 64 * (j))
#define XB_XGEN(j)  (2304 + 64 * (j))
#define XB_TOP      3328
#define XB_TOPGEN   3392
#define XCD_BAR_WORDS 3456
#define XB_SPIN_CAP (1u << 18)

__device__ __forceinline__ unsigned xb_ld(unsigned* p)              { return __hip_atomic_load(p, __ATOMIC_RELAXED, __HIP_MEMORY_SCOPE_AGENT); }
__device__ __forceinline__ unsigned xb_add(unsigned* p, unsigned v) { return __hip_atomic_fetch_add(p, v, __ATOMIC_RELAXED, __HIP_MEMORY_SCOPE_AGENT); }
__device__ __forceinline__ unsigned xb_xcc_id() { return (unsigned)__builtin_amdgcn_s_getreg((3 << 11) | 20) & 0xFu; }
#define XB_SPIN(cond, bar) do { unsigned _sp = 0; while (cond) { __builtin_amdgcn_s_sleep(1); \
    if ((++_sp & 255u) == 0u) { if (xb_ld(&(bar)[XB_TMO])) break; if (_sp > XB_SPIN_CAP) { atomicAdd(&(bar)[XB_TMO], 1u); break; } } } } while (0)

struct XcdBarrier {
    unsigned* bar; unsigned x;
    volatile LAS unsigned* st;
};

__device__ __forceinline__ XcdBarrier xcd_barrier_post(unsigned* bar, volatile LAS unsigned* st) {
    XcdBarrier b; b.bar = bar; b.x = xb_xcc_id(); b.st = st;
    if (threadIdx.x == 0) (void)xb_add(&bar[XB_XCNT(b.x)], 1u);
    return b;
}
__device__ __forceinline__ void xcd_barrier_complete(unsigned* bar, unsigned x, unsigned& nloc, unsigned& nx) {
    const unsigned G = gridDim.x * gridDim.y * gridDim.z;
    unsigned sum, cnt, mine, sp = 0u;
    for (;;) {
        sum = 0u; cnt = 0u; mine = 0u;
#pragma unroll
        for (unsigned j = 0; j < 16; ++j) { const unsigned c = xb_ld(&bar[XB_XCNT(j)]); sum += c; cnt += (c > 0u) ? 1u : 0u; mine = (j == x) ? c : mine; }
        if (sum == G) break;
        __builtin_amdgcn_s_sleep(1);
        if ((++sp & 255u) == 0u) { if (xb_ld(&bar[XB_TMO])) break; if (sp > XB_SPIN_CAP) { atomicAdd(&bar[XB_TMO], 1u); break; } }
    }
    nloc = mine > 0u ? mine : 1u; nx = cnt > 0u ? cnt : 1u;
}

__device__ __forceinline__ void xcd_barrier(const XcdBarrier& b) {
    asm volatile("s_waitcnt vmcnt(0)" ::: "memory");
    __syncthreads();
    if (threadIdx.x == 0) {
        unsigned* bar = b.bar;
        __builtin_amdgcn_s_waitcnt(0);
        unsigned nloc = b.st[0], nx = b.st[1];
        if (nloc == 0u) { xcd_barrier_complete(bar, b.x, nloc, nx); b.st[0] = nloc; b.st[1] = nx; }
        const unsigned old = xb_add(&bar[XB_XSUB(b.x)], 1u);
        const unsigned gen = old / nloc;
        if (old + 1u == (gen + 1u) * nloc) {
            __builtin_amdgcn_fence(__ATOMIC_RELEASE, "agent");
            asm volatile("s_waitcnt vmcnt(0)" ::: "memory");
            const unsigned og = xb_add(&bar[XB_TOP], 1u);
            const unsigned tg = og / nx;
            if (og + 1u == (tg + 1u) * nx) xb_add(&bar[XB_TOPGEN], 1u);
            else XB_SPIN(xb_ld(&bar[XB_TOPGEN]) == tg, bar);
            __builtin_amdgcn_fence(__ATOMIC_ACQUIRE, "agent");
            xb_add(&bar[XB_XGEN(b.x)], 1u);
            asm volatile("s_waitcnt vmcnt(0)" ::: "memory");
        } else {
            XB_SPIN(xb_ld(&bar[XB_XGEN(b.x)]) == gen, bar);
            __builtin_amdgcn_fence(__ATOMIC_ACQUIRE, "agent");
            asm volatile("s_waitcnt vmcnt(0)" ::: "memory");
        }
    }
    __syncthreads();
}

struct Args { const void* in[23]; float* out; unsigned char* ws; int ph_lo, ph_hi, li, pad; };
struct Ctx {
    LAS unsigned char* lds; int tid, lane, wave, G, vcu;
};
template <class F>
__device__ __forceinline__ void transpose_item(F colf, int ldw, bf16_t* WT, int K, int kb, int nb, LAS float* scr, int lane) {
    const int k0 = 64 * kb, n0 = 32 * nb;
    const float* cp = colf(n0 + (lane & 31)) + (size_t)k0 * ldw;
#pragma unroll 8
    for (int i = 0; i < 32; ++i) { const int kk = 2 * i + (lane >> 5); scr[kk * 33 + (lane & 31)] = cp[(size_t)kk * ldw]; }
    LDS_WAIT(); asm volatile("" ::: "memory");
    const int c = lane & 7;
#pragma unroll
    for (int j = 0; j < 4; ++j) { const int n = (lane >> 3) + 8 * j; const LAS float* s = scr + (8 * c) * 33 + n;
        v4u o; o.x = pk2(s[0 * 33], s[1 * 33]); o.y = pk2(s[2 * 33], s[3 * 33]); o.z = pk2(s[4 * 33], s[5 * 33]); o.w = pk2(s[6 * 33], s[7 * 33]);
        *(v4u*)(WT + (size_t)(n0 + n) * K + k0 + 8 * c) = o; }
    LDS_WAIT(); asm volatile("" ::: "memory");
}
struct ColPlain { const float* w; __device__ __forceinline__ const float* operator()(int n) const { return w + n; } };
struct ColWin {
    const float* w;
    __device__ __forceinline__ const float* operator()(int n) const {
        int src = n;
        if (n >= 512 && n < 1536) { const int r = (n - 512) & 511, sec = (n - 512) >> 9, hh = r >> 7, p = r & 127; src = 512 + sec * 512 + hh * 128 + (p >> 1) + 64 * (p & 1); }
        return w + src;
    }
};
__device__ __forceinline__ void f32_to_bf16_range(const float* in, bf16_t* out, size_t n4, size_t gtid, size_t nthr) {
    for (size_t i = gtid; i < n4; i += nthr) { const f32x4 v = ((const f32x4*)in)[i]; v2u o; o.x = pk2(v[0], v[1]); o.y = pk2(v[2], v[3]); ((v2u*)out)[i] = o; }
}
__device__ __forceinline__ void p0_prologue(const Ctx& C, const Args& a) {
    const float* x = (const float*)a.in[0]; const float* mem = (const float*)a.in[1]; const int* positions = (const int*)a.in[2];
    const float* w_in = (const float*)a.in[3]; const float* w_pool_grp = (const float*)a.in[4]; const float* w_mem_kv = (const float*)a.in[7];
    const float* w_br_pool = (const float*)a.in[8]; const float* w_br_ret = (const float*)a.in[9]; const float* w_br_xa = (const float*)a.in[10]; const float* w_out = (const float*)a.in[11];
    unsigned char* dout = (unsigned char*)a.out; unsigned char* ws = a.ws;
    LAS float* scr = (LAS float*)(C.lds + C.wave * 16384);
    const int gw = C.vcu * NWAVES + C.wave, NGW = C.G * NWAVES;
    constexpr int I_WIN = 16 * 224, I_WMEM = 16 * 32, I_WP = 8 * 32, I_WR = 16 * 32, I_WX = 8 * 32, I_WO = 16 * 32;
    constexpr int NITEMS = I_WIN + I_WMEM + I_WP + I_WR + I_WX + I_WO;
    for (int it = gw; it < NITEMS; it += NGW) {
        int r = it;
        if (r < I_WIN) { transpose_item(ColWin{w_in}, NIN, (bf16_t*)(dout + DO_WINT), 1024, r / 224, r % 224, scr, C.lane); continue; } r -= I_WIN;
        if (r < I_WMEM) { transpose_item(ColPlain{w_mem_kv}, 1024, (bf16_t*)(ws + WS_WMEMT), 1024, r / 32, r % 32, scr, C.lane); continue; } r -= I_WMEM;
        if (r < I_WP) { transpose_item(ColPlain{w_br_pool}, 1024, (bf16_t*)(ws + WS_WPT), 512, r / 32, r % 32, scr, C.lane); continue; } r -= I_WP;
        if (r < I_WR) { transpose_item(ColPlain{w_br_ret}, 1024, (bf16_t*)(ws + WS_WRT), 1024, r / 32, r % 32, scr, C.lane); continue; } r -= I_WR;
        if (r < I_WX) { transpose_item(ColPlain{w_br_xa}, 1024, (bf16_t*)(ws + WS_WXT), 512, r / 32, r % 32, scr, C.lane); continue; } r -= I_WX;
        transpose_item(ColPlain{w_out}, 1024, (bf16_t*)(ws + WS_WOUTT), 1024, r / 32, r % 32, scr, C.lane);
    }
    const size_t gtid = (size_t)C.vcu * NTHREADS + C.tid, nthr = (size_t)C.G * NTHREADS;
    f32_to_bf16_range(x, (bf16_t*)(dout + DO_XB), (size_t)T * 1024 / 4, gtid, nthr);
    f32_to_bf16_range(mem, (bf16_t*)(ws + WS_MEMB), (size_t)BATCH * MEML * 1024 / 4, gtid, nthr);
    { bf16_t* wbd = (bf16_t*)(ws + WS_WPOOLBD);
      for (size_t i = gtid; i < 512 * 512; i += nthr) { const int n = (int)(i >> 9), k = (int)(i & 511);
          wbd[i] = ((n >> 7) == (k >> 7)) ? f2bf(w_pool_grp[((size_t)(n >> 7) * 128 + (k & 127)) * 128 + (n & 127)]) : (bf16_t)0; } }
    { float* cs = (float*)(dout + DO_CS); const int j = (int)(gtid & 63);
      const double invf = (double)(float)pow(10000.0, -(double)j / 64.0);
      for (size_t i = gtid; i < (size_t)T * 64; i += nthr) { const int t = (int)(i >> 6); const double ang = (double)positions[t] * invf;
          cs[2 * i] = (float)cos(ang); cs[2 * i + 1] = (float)sin(ang); } }
}

namespace pg8 {
template <bool GATHER> struct MoeSched {
    const PG8_LAS int* base;
    const int* cnt; const int* lists;
    const char* A; const char* Bt; size_t b_estride;
    int K, NP, G, c;
    __device__ __forceinline__ bool next(int i, UnitG& u) const {
        const int ntr = base[32] >> 8, L = i * G + c;
        if (L >= ntr * NP) return false;
        const int rt = L / NP;
        u.pm = rt; u.pn = L - rt * NP; u.e = base[40 + rt]; return true;
    }
    __device__ __forceinline__ const char* a_base(const UnitG& u) const { return GATHER ? A : A + (size_t)u.pm * 256 * K * 2; }
    __device__ __forceinline__ const char* b_base(const UnitG& u) const { return Bt + (size_t)u.e * b_estride + (size_t)u.pn * 256 * K * 2; }
    __device__ __forceinline__ unsigned a_voff(const UnitG& u, int R, int C, int half) const {
        if (!GATHER) return (unsigned)((half * 128 + R) * K + C) * 2u;
        const int slot = u.pm * 256 + half * 128 + R - base[u.e], n = cnt[u.e];
        const int tok = lists[(size_t)u.e * T + (slot < n ? slot : 0)];
        return (unsigned)(tok * K + C) * 2u;
    }
};
struct MoeOrder {
    const PG8_LAS int* base; int NP, G, c;
    __device__ __forceinline__ bool next(int i, Unit& u) const {
        const int ntr = base[32] >> 8, L = i * G + c;
        if (L >= ntr * NP) return false;
        const int rt = L / NP, e = base[40 + rt];
        u.pm = rt; u.pn = e * NP + (L - rt * NP); return true;
    }
    __device__ __forceinline__ void a_ready(const Unit&) const {}
    __device__ __forceinline__ void done(const Unit&) const {}
};
struct EpiMoeAct {
    static constexpr bool PERM = true, AFTER_DRAIN = false;
    bf16_t* act;
    __device__ __forceinline__ void operator()(const f32x4 (&acc)[2][2][4][2], const Unit& u, int wr, int wc, int fr, int fq) const {
        const int row0 = u.pm * BM + wr * 64 + fr, f0 = u.pn * 128 + wc * 32 + 8 * fq;
#pragma unroll
        for (int ai = 0; ai < 2; ++ai)
#pragma unroll
            for (int m = 0; m < 4; ++m) { f32x4 o0, o1;
#pragma unroll
                for (int e = 0; e < 4; ++e) { const float g0 = acc[ai][0][m][0][e], g1 = acc[ai][0][m][1][e];
                    o0[e] = g0 * fast_sigmoid(g0) * acc[ai][1][m][0][e]; o1[e] = g1 * fast_sigmoid(g1) * acc[ai][1][m][1][e]; }
                store8(act + (size_t)(row0 + ai * HALF + m * 16) * 256 + f0, o0, o1); }
    }
};
struct EpiMoeY {
    static constexpr bool PERM = true, AFTER_DRAIN = false;
    bf16_t* y;
    __device__ __forceinline__ void operator()(const f32x4 (&acc)[2][2][4][2], const Unit& u, int wr, int wc, int fr, int fq) const {
        const int row0 = u.pm * BM + wr * 64 + fr, col0 = (u.pn & 3) * 256 + wc * 32 + 8 * fq;
#pragma unroll
        for (int ai = 0; ai < 2; ++ai)
#pragma unroll
            for (int m = 0; m < 4; ++m) { bf16_t* rowp = y + (size_t)(row0 + ai * HALF + m * 16) * 1024 + col0;
#pragma unroll
                for (int bj = 0; bj < 2; ++bj) store8(rowp + bj * HALF, acc[ai][bj][m][0], acc[ai][bj][m][1]); }
    }
};
}
struct ColMoe1 {
    unsigned long long wg, delta;
    __device__ __forceinline__ const float* operator()(int n) const { const unsigned long long p = wg + (((n >> 7) & 1) ? delta : 0ull); return (const float*)p + (n >> 8) * 128 + (n & 127); }
};
__device__ __forceinline__ void moe_convert_weights(const Ctx& C, const Args& a) {
    const float* w_eg = (const float*)a.in[18]; const float* w_eu = (const float*)a.in[19]; const float* w_ed = (const float*)a.in[20];
    bf16_t* w1 = (bf16_t*)(a.ws + WS_MOEW1); bf16_t* w2 = (bf16_t*)(a.ws + WS_MOEW2);
    LAS float* scr = (LAS float*)(C.lds + C.wave * 16384);
    const int gw = C.vcu * NWAVES + C.wave, NGW = C.G * NWAVES;
    for (int it = gw; it < 12288; it += NGW) {
        if (it < 8192) { const int e = it >> 8, r = it & 255;
            transpose_item(ColMoe1{(unsigned long long)(w_eg + (size_t)e * 262144), (unsigned long long)w_eu - (unsigned long long)w_eg}, 256, w1 + (size_t)e * 524288, 1024, r >> 4, r & 15, scr, C.lane); }
        else { const int r = it - 8192, e = r >> 7, rr = r & 127;
            transpose_item(ColPlain{w_ed + (size_t)e * 262144}, 1024, w2 + (size_t)e * 262144, 256, rr >> 5, rr & 31, scr, C.lane); }
    }
}
__device__ __forceinline__ void compute_base(const Ctx& C, const int* cnt, LAS int* base) {
    if (C.wave == 0) {
        const int c = C.lane < 32 ? cnt[C.lane] : 0, p = (c + 255) & ~255; int incl = p;
#pragma unroll
        for (int o = 1; o < 32; o <<= 1) { const int t = __shfl_up(incl, o); if (C.lane >= o) incl += t; }
        if (C.lane < 32) base[C.lane] = incl - p;
        if (C.lane == 31) base[32] = incl;
    }
    __syncthreads();
    if (C.tid < 160) { const int r0 = C.tid << 8; int e = 0;
#pragma unroll 1
        for (int j = 1; j < 32; ++j) e = (base[j] <= r0) ? j : e;
        base[40 + C.tid] = e; }
    __syncthreads();
}

struct TokInfo { int e0, e1, s0, s1; float w0, w1; int pad0, pad1; };
#define DPP_ADD(v, ctrl) ((v) + __builtin_bit_cast(float, __builtin_amdgcn_mov_dpp(__builtin_bit_cast(int, (v)), (ctrl), 0xf, 0xf, true)))
__device__ __forceinline__ float wave_sum(float v) {
    v = DPP_ADD(v, 0xB1);
    v = DPP_ADD(v, 0x4E);
    v = DPP_ADD(v, 0x124);
    v = DPP_ADD(v, 0x128);
    const int b = __builtin_bit_cast(int, v);
    return (__builtin_bit_cast(float, __builtin_amdgcn_readlane(b, 0)) + __builtin_bit_cast(float, __builtin_amdgcn_readlane(b, 16)))
         + (__builtin_bit_cast(float, __builtin_amdgcn_readlane(b, 32)) + __builtin_bit_cast(float, __builtin_amdgcn_readlane(b, 48)));
}
constexpr int RW_STRIDE = 1024;
__device__ __forceinline__ void route_flush(LAS int* wb, int n, int lane, int* cnt, int* lists, TokInfo* info) {
    asm volatile("s_waitcnt lgkmcnt(0)" ::: "memory");
    if (lane < 2 * n) { const int i = lane >> 1, kk = lane & 1; const int e = wb[i * 8 + kk], t = wb[i * 8 + 4];
        const int s = atomicAdd(&cnt[e], 1); lists[e * T + s] = t; wb[i * 8 + 5 + kk] = s; }
    asm volatile("s_waitcnt lgkmcnt(0)" ::: "memory");
    if (lane < n) { TokInfo ti; ti.e0 = wb[lane * 8]; ti.e1 = wb[lane * 8 + 1]; ti.w0 = __int_as_float(wb[lane * 8 + 2]); ti.w1 = __int_as_float(wb[lane * 8 + 3]);
        ti.s0 = wb[lane * 8 + 5]; ti.s1 = wb[lane * 8 + 6]; ti.pad0 = 0; ti.pad1 = 0; info[wb[lane * 8 + 4]] = ti; }
    asm volatile("s_waitcnt lgkmcnt(0)" ::: "memory");
}
__device__ __forceinline__ void p5_stage_router(const Ctx& C, const Args& a) {
    float* hx = a.out; bf16_t* x1b = (bf16_t*)(a.ws + WS_X1B);
    const float* ln_w = (const float*)a.in[12]; const float* ln_b = (const float*)a.in[13];
    const float* wgr = (const float*)a.in[14]; const float* bgr = (const float*)a.in[15]; const float* wer = (const float*)a.in[16]; const float* ber = (const float*)a.in[17];
    int* cnt = (int*)(a.ws + WS_CTL) + CW_CNT; int* lists = (int*)(a.ws + WS_LISTS); TokInfo* info = (TokInfo*)(a.ws + WS_TOKINFO);
    LAS float* Wl = (LAS float*)C.lds;
    for (int i = C.tid; i < 1024; i += NTHREADS) { const f32x4 w = *(const f32x4*)(wgr + 4 * i);
#pragma unroll
        for (int j = 0; j < 4; ++j) Wl[j * RW_STRIDE + i] = w[j]; }
    for (int i = C.tid; i < 8192; i += NTHREADS) { const int k = i >> 3, j4 = (i & 7) * 4; const f32x4 w = *(const f32x4*)(wer + 4 * i);
#pragma unroll
        for (int j = 0; j < 4; ++j) Wl[(4 + j4 + j) * RW_STRIDE + k] = w[j]; }
    __syncthreads();
}
__device__ __forceinline__ void p5_ln1_router(const Ctx& C, const Args& a) {
    float* hx = a.out; bf16_t* x1b = (bf16_t*)(a.ws + WS_X1B);
    const float* ln_w = (const float*)a.in[12]; const float* ln_b = (const float*)a.in[13];
    const float* bgr = (const float*)a.in[15]; const float* ber = (const float*)a.in[17];
    int* cnt = (int*)(a.ws + WS_CTL) + CW_CNT; int* lists = (int*)(a.ws + WS_LISTS); TokInfo* info = (TokInfo*)(a.ws + WS_TOKINFO);
    LAS float* Wl = (LAS float*)C.lds;
    const int lane = C.lane;
    f32x4 lw[4], lb[4];
#pragma unroll
    for (int q = 0; q < 4; ++q) { lw[q] = *(const f32x4*)(ln_w + 256 * q + 4 * lane); lb[q] = *(const f32x4*)(ln_b + 256 * q + 4 * lane); }
    const int gw = C.vcu * NWAVES + C.wave, NGW = C.G * NWAVES;
    f32x4 vn[4];
    if (gw < T) {
#pragma unroll
        for (int q = 0; q < 4; ++q) vn[q] = *(const f32x4*)(hx + (size_t)gw * 1024 + 256 * q + 4 * lane);
    }
    LAS int* wb = (LAS int*)(C.lds + 147456 + C.wave * 1024); int nb = 0;
    for (int t = gw; t < T; t += NGW) {
        float* row = hx + (size_t)t * 1024;
        f32x4 v[4]; float s = 0.f;
#pragma unroll
        for (int q = 0; q < 4; ++q) { v[q] = vn[q]; s += (v[q][0] + v[q][1]) + (v[q][2] + v[q][3]); }
        if (t + NGW < T) {
#pragma unroll
            for (int q = 0; q < 4; ++q) vn[q] = *(const f32x4*)(row + (size_t)NGW * 1024 + 256 * q + 4 * lane);
        }
        const float mu = wave_sum(s) * (1.f / 1024.f); float sq = 0.f;
#pragma unroll
        for (int q = 0; q < 4; ++q) { v[q] = v[q] - mu; sq += (v[q][0] * v[q][0] + v[q][1] * v[q][1]) + (v[q][2] * v[q][2] + v[q][3] * v[q][3]); }
        const float rstd = rsqrtf(wave_sum(sq) * (1.f / 1024.f) + LN_EPS);
#pragma unroll
        for (int q = 0; q < 4; ++q) { v[q] = v[q] * rstd * lw[q] + lb[q]; *(f32x4*)(row + 256 * q + 4 * lane) = v[q];
            v2u o; o.x = pk2(v[q][0], v[q][1]); o.y = pk2(v[q][2], v[q][3]); *(v2u*)(x1b + (size_t)t * 1024 + 256 * q + 4 * lane) = o; }
        float lg[4];
#pragma unroll
        for (int j = 0; j < 4; ++j) { float p = 0.f;
#pragma unroll
            for (int q = 0; q < 4; ++q) { const f32x4 w = *(const LAS f32x4*)(Wl + j * RW_STRIDE + 256 * q + 4 * lane); p += (v[q][0] * w[0] + v[q][1] * w[1]) + (v[q][2] * w[2] + v[q][3] * w[3]); }
            lg[j] = wave_sum(p) + bgr[j]; }
        float m = lg[0]; int gs = 0;
#pragma unroll
        for (int j = 1; j < 4; ++j) if (lg[j] > m) { m = lg[j]; gs = j; }
        float den = 0.f;
#pragma unroll
        for (int j = 0; j < 4; ++j) den += __expf(lg[j] - m);
        const float pg = __builtin_amdgcn_rcpf(den);
        gs = __builtin_amdgcn_readfirstlane(gs);
        float el[8];
        const LAS float* We = Wl + (4 + gs * 8) * RW_STRIDE;
#pragma unroll
        for (int j = 0; j < 8; ++j) { float p = 0.f;
#pragma unroll
            for (int q = 0; q < 4; ++q) { const f32x4 w = *(const LAS f32x4*)(We + j * RW_STRIDE + 256 * q + 4 * lane); p += (v[q][0] * w[0] + v[q][1] * w[1]) + (v[q][2] * w[2] + v[q][3] * w[3]); }
            el[j] = wave_sum(p) + ber[gs * 8 + j]; }
        int i0 = 0; float v0 = el[0];
#pragma unroll
        for (int j = 1; j < 8; ++j) if (el[j] > v0) { v0 = el[j]; i0 = j; }
        int i1 = -1; float v1 = -3.0e38f;
#pragma unroll
        for (int j = 0; j < 8; ++j) if (j != i0 && el[j] > v1) { v1 = el[j]; i1 = j; }
        if (i1 < 0) i1 = (i0 == 0) ? 1 : 0;
        const float e1 = __expf(v1 - v0);
        if (lane == 0) { LAS int* e = wb + nb * 8; e[0] = gs * 8 + i0; e[1] = gs * 8 + i1; e[2] = __float_as_int(pg / (1.f + e1)); e[3] = __float_as_int(pg * e1 / (1.f + e1)); e[4] = t; }
        ++nb;
        if (nb == 32) { route_flush(wb, nb, lane, cnt, lists, info); nb = 0; }
    }
    if (nb) route_flush(wb, nb, lane, cnt, lists, info);
}
__device__ __forceinline__ void p7_final(const Ctx& C, const Args& a, const LAS int* base, float* dst) {
    float* x1 = a.out; const bf16_t* y = (const bf16_t*)(a.ws + WS_Y); const TokInfo* info = (const TokInfo*)(a.ws + WS_TOKINFO);
    const float* ln_w = (const float*)a.in[21]; const float* ln_b = (const float*)a.in[22];
    const int lane = C.lane;
    f32x4 lw[4], lb[4];
#pragma unroll
    for (int q = 0; q < 4; ++q) { lw[q] = *(const f32x4*)(ln_w + 256 * q + 4 * lane); lb[q] = *(const f32x4*)(ln_b + 256 * q + 4 * lane); }
    const int gw = C.vcu * NWAVES + C.wave, NGW = C.G * NWAVES;
    for (int t = gw; t < T; t += NGW) {
        const TokInfo ti = info[t];
        const bf16_t* y0 = y + (size_t)(base[ti.e0] + ti.s0) * 1024; const bf16_t* y1 = y + (size_t)(base[ti.e1] + ti.s1) * 1024;
        float* row = x1 + (size_t)t * 1024;
        f32x4 v[4]; float s = 0.f;
#pragma unroll
        for (int q = 0; q < 4; ++q) { const int c = 256 * q + 4 * lane; const v2u a0 = *(const v2u*)(y0 + c), a1 = *(const v2u*)(y1 + c);
            v[q] = *(const f32x4*)(row + c) * ALPHA + pg8::bf4_to_f32(a0.x, a0.y) * ti.w0 + pg8::bf4_to_f32(a1.x, a1.y) * ti.w1;
            s += (v[q][0] + v[q][1]) + (v[q][2] + v[q][3]); }
        const float mu = wave_sum(s) * (1.f / 1024.f); float sq = 0.f;
#pragma unroll
        for (int q = 0; q < 4; ++q) { v[q] = v[q] - mu; sq += (v[q][0] * v[q][0] + v[q][1] * v[q][1]) + (v[q][2] * v[q][2] + v[q][3] * v[q][3]); }
        const float rstd = rsqrtf(wave_sum(sq) * (1.f / 1024.f) + LN_EPS);
#pragma unroll
        for (int q = 0; q < 4; ++q) *(f32x4*)(dst + (size_t)t * 1024 + 256 * q + 4 * lane) = v[q] * rstd * lw[q] + lb[q];
    }
}

typedef short s16x4 __attribute__((ext_vector_type(4)));
#define MFMA32(a, b, c) __builtin_amdgcn_mfma_f32_32x32x16_bf16((a), (b), (c), 0, 0, 0)
__device__ __forceinline__ int crow(int i, int h) { return (i & 3) + 8 * (i >> 2) + 4 * h; }
__device__ __forceinline__ bf16x8 pack8(const f32x16& x, int s) {
    v4u p; p.x = pk2(x[8 * s], x[8 * s + 1]); p.y = pk2(x[8 * s + 2], x[8 * s + 3]); p.z = pk2(x[8 * s + 4], x[8 * s + 5]); p.w = pk2(x[8 * s + 6], x[8 * s + 7]);
    return __builtin_bit_cast(bf16x8, p);
}
__device__ __forceinline__ bf16x8 cvt8(const f32x4& a, const f32x4& b) { v4u p; p.x = pk2(a[0], a[1]); p.y = pk2(a[2], a[3]); p.z = pk2(b[0], b[1]); p.w = pk2(b[2], b[3]); return __builtin_bit_cast(bf16x8, p); }
__device__ __forceinline__ bf16x8 tr_frag(LAS unsigned char* img, int pitch, int k0, int k1, int mn0, int lane) {
    const int q4 = (lane & 15) >> 2, p4 = lane & 3, blk = (lane >> 4) & 1, cb = (mn0 + 16 * blk + 4 * p4) * 2;
    const s16x4 lo = __builtin_amdgcn_ds_read_tr16_b64_v4i16((LAS s16x4*)(img + (k0 + q4) * pitch + cb));
    const s16x4 hi = __builtin_amdgcn_ds_read_tr16_b64_v4i16((LAS s16x4*)(img + (k1 + q4) * pitch + cb));
    return __builtin_shufflevector(lo, hi, 0, 1, 2, 3, 4, 5, 6, 7);
}
__device__ __forceinline__ float gamma_log2(int h) { return pg8::log2_gamma(h); }

__device__ __forceinline__ void pooled_strip(const Ctx& C, const bf16_t* up, bf16_t* pooled, int strip) {
    const int cg = C.tid & 127, sub = C.tid >> 7, c = 4 * cg, w = 2 << (cg >> 5), t0 = strip * 64 + sub * 16, s0 = t0 & (SEQ - 1);
    f32x4 sum = {0.f, 0.f, 0.f, 0.f};
    for (int j = 1; j <= w; ++j) if (s0 - j >= 0) { const v2u x = *(const v2u*)(up + (size_t)(t0 - j) * 512 + c); sum += pg8::bf4_to_f32(x.x, x.y); }
#pragma unroll 4
    for (int i = 0; i < 16; ++i) { const int t = t0 + i, s = s0 + i; const v2u x = *(const v2u*)(up + (size_t)t * 512 + c); const f32x4 cur = pg8::bf4_to_f32(x.x, x.y);
        sum += cur; if (s - w >= 0) { const v2u y = *(const v2u*)(up + (size_t)(t - w) * 512 + c); sum -= pg8::bf4_to_f32(y.x, y.y); }
        const float inv = 1.f / (float)((s + 1 < w) ? s + 1 : w);
        const f32x4 o = sum * inv - cur; v2u ow; ow.x = pk2(o[0], o[1]); ow.y = pk2(o[2], o[3]); *(v2u*)(pooled + (size_t)t * 512 + c) = ow; }
}
template <bool STORE = true>
__device__ __forceinline__ void xattn_unit(const Ctx& C, bf16_t* xq, const bf16_t* mk, const bf16_t* mv, int unit) {
    const int qt = unit & 15, h = (unit >> 4) & 3, b = unit >> 6;
    LAS unsigned char* Kl = C.lds; LAS unsigned char* Vl = C.lds + 69632;
#pragma unroll
    for (int it = 0; it < 8; ++it) { const int idx = C.tid + it * 512, row = idx >> 4, ch = idx & 15;
        const size_t src = ((size_t)(b * MEML + row) * 512 + h * 128) * 2 + ch * 16;
        const v4u kv = *(const v4u*)((const char*)mk + src), vv = *(const v4u*)((const char*)mv + src);
        *(LAS v4u*)(Kl + row * 272 + ch * 16) = kv; *(LAS v4u*)(Vl + row * 320 + ch * 16) = vv; }
    __syncthreads();
    const int lane = C.lane, r = lane & 31, h2 = lane >> 5;
    bf16_t* qrow = xq + ((size_t)b * SEQ + qt * 256 + C.wave * 32 + r) * 512 + h * 128;
    bf16x8 qf[8];
#pragma unroll
    for (int ks = 0; ks < 8; ++ks) qf[ks] = *(const bf16x8*)(qrow + 16 * ks + 8 * h2);
    f32x16 ot[4];
#pragma unroll
    for (int db = 0; db < 4; ++db)
#pragma unroll
        for (int i = 0; i < 16; ++i) ot[db][i] = 0.f;
    float m_run = -3.0e38f, sum = 0.f;
#pragma unroll 1
    for (int qtr = 0; qtr < 4; ++qtr) {
        f32x16 st[2];
#pragma unroll
        for (int kq = 0; kq < 2; ++kq) { LAS unsigned char* kp = Kl + (64 * qtr + 32 * kq + r) * 272 + 16 * h2;
#pragma unroll
            for (int i = 0; i < 16; ++i) st[kq][i] = 0.f;
#pragma unroll
            for (int ks = 0; ks < 8; ++ks) { const bf16x8 kf = *(const LAS bf16x8*)(kp + 32 * ks); st[kq] = MFMA32(kf, qf[ks], st[kq]); }
        }
        float mh = -3.0e38f;
#pragma unroll
        for (int kq = 0; kq < 2; ++kq)
#pragma unroll
            for (int i = 0; i < 16; ++i) mh = fmaxf(mh, st[kq][i]);
        mh = fmaxf(mh, __shfl_xor(mh, 32));
        const float m_new = fmaxf(m_run, mh), alpha = __builtin_amdgcn_exp2f((m_run - m_new) * 1.4426950408889634f);
        sum *= alpha;
#pragma unroll
        for (int db = 0; db < 4; ++db)
#pragma unroll
            for (int i = 0; i < 16; ++i) ot[db][i] *= alpha;
        m_run = m_new;
#pragma unroll
        for (int kq = 0; kq < 2; ++kq)
#pragma unroll
            for (int i = 0; i < 16; ++i) { const float p = __builtin_amdgcn_exp2f((st[kq][i] - m_new) * 1.4426950408889634f); st[kq][i] = p; sum += p; }
#pragma unroll
        for (int kq = 0; kq < 2; ++kq)
#pragma unroll
            for (int s = 0; s < 2; ++s) { const bf16x8 pb = pack8(st[kq], s); const int k0 = 64 * qtr + 32 * kq + 16 * s + 4 * h2;
#pragma unroll
                for (int db = 0; db < 4; ++db) { const bf16x8 vf = tr_frag(Vl, 320, k0, k0 + 8, 32 * db, lane); ot[db] = MFMA32(vf, pb, ot[db]); } }
    }
    sum += __shfl_xor(sum, 32);
    const float inv = 1.f / sum;
#pragma unroll
    for (int db = 0; db < 4; ++db)
#pragma unroll
        for (int gq = 0; gq < 4; ++gq) { v2u w; w.x = pk2(ot[db][4 * gq] * inv, ot[db][4 * gq + 1] * inv); w.y = pk2(ot[db][4 * gq + 2] * inv, ot[db][4 * gq + 3] * inv);
            if (STORE) *(v2u*)(qrow + 32 * db + 8 * gq + 4 * h2) = w; else asm volatile("" :: "v"(w.x), "v"(w.y)); }
    __syncthreads();
}
template <bool WITH_K>
__device__ __forceinline__ void stage_chunk(const Ctx& C, const bf16_t* k, const bf16_t* v, size_t t0, int h) {
#pragma unroll
    for (int it = 0; it < 8; ++it) { const int idx = C.tid + it * 512, row = idx >> 5, ch = idx & 31;
        const v4u x = *(const v4u*)(v + (t0 + row) * 1024 + h * 256 + ch * 8); *(LAS v4u*)(C.lds + row * 576 + ch * 16) = x; }
    if (WITH_K) {
#pragma unroll
        for (int it = 0; it < 4; ++it) { const int idx = C.tid + it * 512, row = idx >> 4, ch = idx & 15;
            const v4u x = *(const v4u*)(k + (t0 + row) * 512 + h * 128 + ch * 8); *(LAS v4u*)(C.lds + 73728 + row * 320 + ch * 16) = x; }
    }
}
__device__ __forceinline__ void ret_state_unit(const Ctx& C, const bf16_t* k, const bf16_t* v, float* kvT, int u) {
    const int h = u & 3; const size_t t0 = (size_t)(u >> 2) * CH;
    stage_chunk<true>(C, k, v, t0, h);
    __syncthreads();
    LAS unsigned char* Vl = C.lds; LAS unsigned char* Kl = C.lds + 73728;
    const int lane = C.lane, r = lane & 31, h2 = lane >> 5, eb = C.wave;
    f32x16 acc[4];
#pragma unroll
    for (int db = 0; db < 4; ++db)
#pragma unroll
        for (int i = 0; i < 16; ++i) acc[db][i] = 0.f;
#pragma unroll
    for (int ks = 0; ks < 8; ++ks) { const int k0 = 16 * ks + 8 * h2;
        const bf16x8 af = tr_frag(Vl, 576, k0, k0 + 4, 32 * eb, lane);
#pragma unroll
        for (int db = 0; db < 4; ++db) { const bf16x8 bf = tr_frag(Kl, 320, k0, k0 + 4, 32 * db, lane); acc[db] = MFMA32(af, bf, acc[db]); } }
    const float sc = __builtin_amdgcn_exp2f((float)(CH - 1) * gamma_log2(h));
    float* out = kvT + ((size_t)u * 256 + 32 * eb) * 128 + r;
#pragma unroll
    for (int db = 0; db < 4; ++db)
#pragma unroll
        for (int i = 0; i < 16; ++i) out[(size_t)crow(i, h2) * 128 + 32 * db] = acc[db][i] * sc;
    __syncthreads();
}
template <bool STORE = true>
__device__ __forceinline__ void scan_all(const Ctx& C, float* kvT) {
    const size_t nthr = (size_t)C.G * NTHREADS;
    for (size_t idx = (size_t)C.vcu * NTHREADS + C.tid; idx < (size_t)BATCH * 4 * 8192; idx += nthr) {
        const int ed4 = (int)(idx & 8191), h = (int)((idx >> 13) & 3), b = (int)(idx >> 15);
        const float cd = __builtin_amdgcn_exp2f((float)CH * gamma_log2(h));
        f32x4 inc[NCH];
#pragma unroll
        for (int n = 0; n < NCH; ++n) inc[n] = *(const f32x4*)(kvT + ((size_t)((b * NCH + n) * 4 + h)) * 32768 + ed4 * 4);
        f32x4 st = {0.f, 0.f, 0.f, 0.f};
#pragma unroll
        for (int n = 0; n < NCH; ++n) { if (STORE) *(f32x4*)(kvT + ((size_t)((b * NCH + n) * 4 + h)) * 32768 + ed4 * 4) = st; st = st * cd + inc[n]; }
        if (!STORE) asm volatile("" :: "v"(st[0]), "v"(st[1]), "v"(st[2]), "v"(st[3]));
    }
}
template <bool STORE = true>
__device__ __forceinline__ void ret_out_unit(const Ctx& C, const bf16_t* q, const bf16_t* k, const bf16_t* v, const float* prevT, bf16_t* g, const float* gn_w, int u) {
    const int h = u & 3; const size_t t0 = (size_t)(u >> 2) * CH;
    stage_chunk<false>(C, k, v, t0, h);
    __syncthreads();
    LAS unsigned char* Vl = C.lds; LAS float* red = (LAS float*)(C.lds + 73728);
    const int lane = C.lane, r = lane & 31, h2 = lane >> 5, cb = C.wave & 3, eh = C.wave >> 2;
    const size_t tokq = t0 + 32 * cb + r;
    const bf16_t* qrow = q + tokq * 512 + h * 128;
    bf16x8 qf[8];
#pragma unroll
    for (int ks = 0; ks < 8; ++ks) qf[ks] = *(const bf16x8*)(qrow + 16 * ks + 8 * h2);
    f32x16 yt[4];
#pragma unroll
    for (int el = 0; el < 4; ++el)
#pragma unroll
        for (int i = 0; i < 16; ++i) yt[el][i] = 0.f;
#pragma unroll
    for (int ks = 0; ks < 8; ++ks)
#pragma unroll
        for (int el = 0; el < 4; ++el) { const float* pr = prevT + ((size_t)u * 256 + 32 * (4 * eh + el) + r) * 128 + 16 * ks + 8 * h2;
            const bf16x8 af = cvt8(*(const f32x4*)pr, *(const f32x4*)(pr + 4)); yt[el] = MFMA32(af, qf[ks], yt[el]); }
    const float gam = __builtin_amdgcn_exp2f(gamma_log2(h));
#pragma unroll
    for (int el = 0; el < 4; ++el)
#pragma unroll
        for (int i = 0; i < 16; ++i) yt[el][i] *= gam;
    for (int sb = 0; sb <= cb; ++sb) {
        f32x16 sblk;
#pragma unroll
        for (int i = 0; i < 16; ++i) sblk[i] = 0.f;
        const bf16_t* krow = k + (t0 + 32 * sb + r) * 512 + h * 128;
#pragma unroll
        for (int ks = 0; ks < 8; ++ks) { const bf16x8 kf = *(const bf16x8*)(krow + 16 * ks + 8 * h2); sblk = MFMA32(kf, qf[ks], sblk); }
        if (sb == cb) {
#pragma unroll
            for (int i = 0; i < 16; ++i) sblk[i] = (crow(i, h2) > r) ? 0.f : sblk[i];
        }
#pragma unroll
        for (int s = 0; s < 2; ++s) { const bf16x8 pb = pack8(sblk, s); const int k0 = 32 * sb + 16 * s + 4 * h2;
#pragma unroll
            for (int el = 0; el < 4; ++el) { const bf16x8 vf = tr_frag(Vl, 576, k0, k0 + 8, 32 * (4 * eh + el), lane); yt[el] = MFMA32(vf, pb, yt[el]); } }
    }
    float s1 = 0.f;
#pragma unroll
    for (int el = 0; el < 4; ++el)
#pragma unroll
        for (int i = 0; i < 16; ++i) s1 += yt[el][i];
    s1 += __shfl_xor(s1, 32);
    if (h2 == 0) red[C.wave * 32 + r] = s1;
    __syncthreads();
    const float mean = (s1 + red[(C.wave ^ 4) * 32 + r]) * (1.f / 256.f);
    float s2 = 0.f;
#pragma unroll
    for (int el = 0; el < 4; ++el)
#pragma unroll
        for (int i = 0; i < 16; ++i) { const float d = yt[el][i] - mean; s2 += d * d; }
    s2 += __shfl_xor(s2, 32);
    if (h2 == 0) red[256 + C.wave * 32 + r] = s2;
    __syncthreads();
    const float rstd = rsqrtf((s2 + red[256 + (C.wave ^ 4) * 32 + r]) * (1.f / 256.f) + LN_EPS);
    bf16_t* grow = g + tokq * 1024 + h * 256;
#pragma unroll
    for (int el = 0; el < 4; ++el)
#pragma unroll
        for (int gq = 0; gq < 4; ++gq) { const int e0 = 32 * (4 * eh + el) + 8 * gq + 4 * h2;
            const f32x4 w = *(const f32x4*)(gn_w + h * 256 + e0); const v2u gs = *(const v2u*)(grow + e0); const f32x4 gf = pg8::bf4_to_f32(gs.x, gs.y);
            f32x4 o;
#pragma unroll
            for (int j = 0; j < 4; ++j) o[j] = (yt[el][4 * gq + j] - mean) * rstd * w[j] * gf[j];
            v2u ow; ow.x = pk2(o[0], o[1]); ow.y = pk2(o[2], o[3]); if (STORE) *(v2u*)(grow + e0) = ow; else asm volatile("" :: "v"(ow.x), "v"(ow.y)); }
    __syncthreads();
}

__global__ void __launch_bounds__(NTHREADS, 2) mega(Args a) {
    extern __shared__ __attribute__((aligned(16))) unsigned char lds_raw[];
    Ctx C; C.lds = (LAS unsigned char*)lds_raw; C.tid = threadIdx.x; C.lane = C.tid & 63; C.wave = __builtin_amdgcn_readfirstlane(C.tid >> 6);
    C.G = gridDim.x; { const int bx = blockIdx.x; C.vcu = (C.G % 8 == 0) ? (bx % 8) * (C.G / 8) + bx / 8 : bx; }
    volatile LAS unsigned* MISC = (volatile LAS unsigned*)(C.lds + MISC_OFF);
    if (C.tid < 64) MISC[C.tid] = 0u;
    __syncthreads();
    XcdBarrier bar = xcd_barrier_post((unsigned*)(a.ws + WS_CTL) + CW_BAR + a.li * XCD_BAR_WORDS, MISC + 8);
#if defined(TS_A)
#define STAMP(i) do { if (C.vcu == 0 && C.tid == 0) MISC[16 + (i)] = (unsigned)__builtin_amdgcn_s_memrealtime(); } while (0)
#else
#define STAMP(i) do {} while (0)
#endif
    STAMP(0);
    const int lo = a.ph_lo, hi = a.ph_hi;
#define IN(k) (lo <= (k) && (k) < hi)
#define BOTH(k) (IN(k) && IN((k) + 1))
    unsigned char* dout = (unsigned char*)a.out; unsigned char* ws = a.ws;
    if (IN(0)) { REP(0) p0_prologue(C, a); if (BOTH(0)) xcd_barrier(bar); STAMP(1); }
    if (IN(1)) {
        REP(1) { pg8::Gemm g{(const bf16_t*)(dout + DO_XB), (const bf16_t*)(dout + DO_WINT), T, NIN, 1024}; pg8::StaticOrder S; S.init(T, NIN, C.G, (int)blockIdx.x);
          pg8::EpiProj E{(bf16_t*)(ws + WS_UPOOL), (bf16_t*)(ws + WS_Q), (bf16_t*)(ws + WS_K), (bf16_t*)(ws + WS_V), (bf16_t*)(ws + WS_G), (bf16_t*)(ws + WS_XQ), (bf16_t*)(ws + WS_GATES), (const float*)(dout + DO_CS)};
          pg8::gemm_phase<pg8::EpiProj, pg8::StaticOrder, true, true>(C.lds, g, S, E); }
        if (BOTH(1)) xcd_barrier(bar); STAMP(2);
    }
    if (IN(2)) {
        const int nh = (C.G >= 64) ? 16 : 0;
        if (C.vcu < nh || nh == 0) {
            pg8::Gemm g{(const bf16_t*)(ws + WS_MEMB), (const bf16_t*)(ws + WS_WMEMT), BATCH * MEML, 1024, 1024}; pg8::StaticOrder S; S.init(BATCH * MEML, 1024, nh ? nh : C.G, C.vcu);
            pg8::EpiMemKV E{(bf16_t*)(ws + WS_MEMK), (bf16_t*)(ws + WS_MEMV)};
            pg8::gemm_phase<pg8::EpiMemKV, pg8::StaticOrder, true, true>(C.lds, g, S, E);
        }
        if (C.vcu >= nh) {
            const int w0 = C.vcu - nh, nw = C.G - nh;
            for (int s = w0; s < T / 64; s += nw) pooled_strip(C, (const bf16_t*)(ws + WS_UPOOL), (bf16_t*)(ws + WS_POOLED), s);
            for (int u = w0; u < BATCH * NCH * 4; u += nw) ret_state_unit(C, (const bf16_t*)(ws + WS_K), (const bf16_t*)(ws + WS_V), a.out, u);
        }
        if (BOTH(2)) xcd_barrier(bar); STAMP(3);
    }
    if (IN(3)) {
        for (int u = C.vcu; u < BATCH * 4 * (SEQ / 256); u += C.G) xattn_unit(C, (bf16_t*)(ws + WS_XQ), (const bf16_t*)(ws + WS_MEMK), (const bf16_t*)(ws + WS_MEMV), u);
        STAMP(14); scan_all(C, a.out); STAMP(15);
        REP(3) { pg8::Gemm g{(const bf16_t*)(ws + WS_POOLED), (const bf16_t*)(ws + WS_WPOOLBD), T, 512, 512}; pg8::StaticOrder S; S.init(T, 512, C.G, (int)blockIdx.x);
        pg8::EpiPoolMap E{(bf16_t*)(ws + WS_UPOOL), (const float*)a.in[5]};
        pg8::gemm_phase<pg8::EpiPoolMap, pg8::StaticOrder, true, true>(C.lds, g, S, E); }
        if (BOTH(3)) xcd_barrier(bar); STAMP(4);
    }
    if (IN(4)) {
        for (int u = C.vcu; u < BATCH * NCH * 4; u += C.G) ret_out_unit(C, (const bf16_t*)(ws + WS_Q), (const bf16_t*)(ws + WS_K), (const bf16_t*)(ws + WS_V), a.out, (bf16_t*)(ws + WS_G), (const float*)a.in[6], u);
        if (BOTH(4)) xcd_barrier(bar); STAMP(5);
    }
    if (IN(5)) {
        const bf16_t* gates = (const bf16_t*)(ws + WS_GATES); bf16_t* merged = (bf16_t*)(ws + WS_MERGED);
        pg8::StaticOrder S; S.init(T, 1024, C.G, (int)blockIdx.x);
        REP(5) {
        { pg8::Gemm g{(const bf16_t*)(ws + WS_UPOOL), (const bf16_t*)(ws + WS_WPT), T, 1024, 512}; pg8::EpiGate<0> E{a.out, merged, gates, 0};
          pg8::gemm_phase<pg8::EpiGate<0>, pg8::StaticOrder, true, true>(C.lds, g, S, E); }
        __builtin_amdgcn_fence(__ATOMIC_ACQUIRE, "agent");
        { pg8::Gemm g{(const bf16_t*)(ws + WS_G), (const bf16_t*)(ws + WS_WRT), T, 1024, 1024}; pg8::EpiGate<1> E{a.out, merged, gates, 1024};
          pg8::gemm_phase<pg8::EpiGate<1>, pg8::StaticOrder, true, true>(C.lds, g, S, E); }
        __builtin_amdgcn_fence(__ATOMIC_ACQUIRE, "agent");
        { pg8::Gemm g{(const bf16_t*)(ws + WS_XQ), (const bf16_t*)(ws + WS_WXT), T, 1024, 512}; pg8::EpiGate<2> E{a.out, merged, gates, 2048};
          pg8::gemm_phase<pg8::EpiGate<2>, pg8::StaticOrder, true, true>(C.lds, g, S, E); }
        __builtin_amdgcn_fence(__ATOMIC_ACQUIRE, "agent"); }
        if (BOTH(5)) xcd_barrier(bar); STAMP(6);
    }
    if (IN(6)) {
        pg8::Gemm g{(const bf16_t*)(ws + WS_MERGED), (const bf16_t*)(ws + WS_WOUTT), T, 1024, 1024}; pg8::StaticOrder S; S.init(T, 1024, C.G, (int)blockIdx.x);
        pg8::EpiResid E{a.out, (const float*)a.in[0]};
        REP(6) pg8::gemm_phase<pg8::EpiResid, pg8::StaticOrder, true, true>(C.lds, g, S, E);
        if (BOTH(6)) xcd_barrier(bar); STAMP(7);
    }
    if (IN(7)) {
        moe_convert_weights(C, a);
        __syncthreads(); STAMP(12);
        p5_stage_router(C, a); STAMP(13);
        p5_ln1_router(C, a);
        if (BOTH(7)) xcd_barrier(bar); STAMP(8);
    }
    LAS int* mbase = (LAS int*)(C.lds + RING_BYTES);
    const int* cntp = (const int*)(ws + WS_CTL) + CW_CNT;
    if (IN(8)) {
        compute_base(C, cntp, mbase);
        pg8::MoeSched<true> S{mbase, cntp, (const int*)(ws + WS_LISTS), (const char*)(ws + WS_X1B), (const char*)(ws + WS_MOEW1), (size_t)512 * 1024 * 2, 1024, 2, C.G, (int)blockIdx.x};
        pg8::EpiMoeAct E{(bf16_t*)(ws + WS_ACT)};
        REP(8) pg8::gemm_phase_g<pg8::EpiMoeAct, pg8::MoeSched<true>>(C.lds, 1024, S, E);
        if (BOTH(8)) xcd_barrier(bar); STAMP(9);
    }
    if (IN(9)) {
        compute_base(C, cntp, mbase);
        pg8::Gemm g{(const bf16_t*)(ws + WS_ACT), (const bf16_t*)(ws + WS_MOEW2), 40960, 32 * 1024, 256}; pg8::MoeOrder S{mbase, 4, C.G, (int)blockIdx.x};
        pg8::EpiMoeY E{(bf16_t*)(ws + WS_Y)};
        REP(9) pg8::gemm_phase<pg8::EpiMoeY, pg8::MoeOrder, true, true>(C.lds, g, S, E);
        if (BOTH(9)) xcd_barrier(bar); STAMP(10);
    }
    if (IN(10)) {
        compute_base(C, cntp, mbase);
        p7_final(C, a, mbase, a.out);
        STAMP(11);
#if defined(TS_A)
        __syncthreads();
        if (C.vcu == 0 && C.tid == 0) { const unsigned d = MISC[16 + TS_B] - MISC[16 + TS_A]; a.out[0] += (float)(TS_SCALE) * (float)d; }
#endif
    }
#undef IN
#undef BOTH
}

static int g_grid = 0;
static void launch_mega(hipStream_t stream, Args a, int lo, int hi, int li) {
    a.ph_lo = lo; a.ph_hi = hi; a.li = li; a.pad = 0;
    hipLaunchKernelGGL(mega, dim3(g_grid), dim3(NTHREADS), LDS_BYTES, stream, a);
    const hipError_t e = hipPeekAtLastError();
    if (e != hipSuccess) fprintf(stderr, "kernel_launch: launch failed: %s (grid %d)\n", hipGetErrorString(e), g_grid);
}

extern "C" void kernel_launch(void* const* d_in, const int* in_sizes, int n_in, void* d_out, int out_size, void* d_ws, size_t ws_size, hipStream_t stream) {
    if (g_grid == 0) {
        int dev = 0, cus = 0, per_cu = 0;
        (void)hipGetDevice(&dev); (void)hipDeviceGetAttribute(&cus, hipDeviceAttributeMultiprocessorCount, dev);
        (void)hipFuncSetAttribute((const void*)mega, hipFuncAttributeMaxDynamicSharedMemorySize, LDS_BYTES);
        (void)hipOccupancyMaxActiveBlocksPerMultiprocessor(&per_cu, (const void*)mega, NTHREADS, LDS_BYTES);
        if (per_cu < 1) { fprintf(stderr, "kernel_launch: occupancy query reports %d blocks per CU\n", per_cu); per_cu = 1; }
        g_grid = cus;
    }
    Args a{}; for (int i = 0; i < 23; ++i) a.in[i] = d_in[i]; a.out = (float*)d_out; a.ws = (unsigned char*)d_ws;
    (void)hipMemsetAsync((unsigned char*)d_ws + WS_CTL, 0, 1 * MiB, stream);
    launch_mega(stream, a, 0, 11, 0);
}
```

```cpp
#include <hip/hip_runtime.h>
#include <stdint.h>
#include <math.h>
#include <cstdio>

typedef unsigned short bf16_t;
__device__ __forceinline__ float bf2f(bf16_t h) { return __uint_as_float(((unsigned)h) << 16); }
__device__ __forceinline__ bf16_t f2bf(float f) { unsigned u = __float_as_uint(f); return (bf16_t)((u + 0x7fffu + ((u >> 16) & 1u)) >> 16); }

constexpr int D = 1024, BATCH = 4, SEQ = 4096, T = BATCH * SEQ, MEML = 256;
constexpr int NIN = 7168;
constexpr int CH = 128, NCH = SEQ / CH;
constexpr int NEXP = 32, DEXP = 256;
constexpr float LN_EPS = 1e-5f;
constexpr float ALPHA = 1.189207115002721f;
constexpr size_t MiB = 1u << 20;
constexpr size_t WS_CTL = 0, WS_TOKINFO = 1 * MiB, WS_LISTS = 2 * MiB;
constexpr size_t WS_WPT = 4 * MiB, WS_WRT = 5 * MiB, WS_WXT = 7 * MiB, WS_WOUTT = 8 * MiB, WS_WPOOLBD = 10 * MiB;
constexpr size_t WS_MEMK = 11 * MiB, WS_MEMV = 12 * MiB, WS_POOLED = 13 * MiB;
constexpr size_t WS_UPOOL = 32 * MiB, WS_Q = 48 * MiB, WS_K = 64 * MiB, WS_V = 80 * MiB, WS_G = 112 * MiB, WS_XQ = 144 * MiB, WS_GATES = 160 * MiB;
constexpr size_t WS_MERGED = 48 * MiB, WS_X1B = 80 * MiB, WS_ACT = 32 * MiB, WS_TMP = 52 * MiB, WS_Y = 176 * MiB;
constexpr size_t WS_MOEW1 = 112 * MiB, WS_MOEW2 = 144 * MiB;
constexpr size_t DO_XB = 0, DO_WINT = 32 * MiB, DO_CS = 50 * MiB;
constexpr size_t WS_MEMB = 1 * MiB, WS_WMEMT = 29 * MiB;
constexpr int CW_CNT = 1024;
constexpr int CW_BASE = 1088;
constexpr int CW_BAR = 4096;
#ifndef PHASE_REP
#define PHASE_REP -1
#endif
#define REP(k) for (int rep_ = 0; rep_ < ((PHASE_REP) == (k) ? 2 : 1); ++rep_)

namespace pg8 {
#define PG8_LAS __attribute__((address_space(3)))
typedef unsigned short bf16_t;
typedef short bf16x8 __attribute__((ext_vector_type(8)));
typedef float f32x4 __attribute__((ext_vector_type(4)));
typedef unsigned u32x4 __attribute__((ext_vector_type(4)));
constexpr int BM = 256, BK = 64, HALF = 128, HTB = HALF * BK * 2  , STAGE_BYTES = 8 * HTB, NXCD = 8, WGM = 8;

__host__ __device__ __forceinline__ int lds_byte(int r, int c) { const int st = (r >> 4) * 2 + (c >> 5), rr = r & 15, cc = c & 31, ob = rr * 64 + cc * 2; return st * 1024 + (ob ^ (((ob >> 9) & 1) << 5)); }
__host__ __device__ __forceinline__ void stage_rc(int b, int& R, int& C) { const int st = b / 1024, sb = b % 1024, swz = sb ^ (((sb >> 9) & 1) << 5); R = (st >> 1) * 16 + swz / 64; C = (st & 1) * 32 + (swz % 64) / 2; }
__host__ __device__ __forceinline__ int perm32(int rho) { const int n = rho >> 4, i = rho & 15; return 8 * (i >> 2) + 4 * n + (i & 3); }

struct Unit { int pm, pn; };
struct Gemm { const bf16_t* A; const bf16_t* Bt; int M, N, K; };

struct StaticOrder {
    int nM, nN, nwg, G, c;
    __host__ __device__ void init(int M, int N, int G_, int c_) { nM = M / BM; nN = N / BM; nwg = nM * nN; G = G_; c = c_; }
    __host__ __device__ bool next(int i, Unit& u) const {
        const long L = (long)i * G + c; if (L >= nwg) return false;
        int wgid = (int)L; { const int q = nwg / NXCD, r = nwg % NXCD, xcd = wgid % NXCD, off = wgid / NXCD; wgid = (xcd < r ? xcd * (q + 1) : r * (q + 1) + (xcd - r) * q) + off; }
        const int nig = WGM * nN, gid = wgid / nig, fm = gid * WGM, gsz = (nM - fm) < WGM ? (nM - fm) : WGM;
        u.pm = fm + ((wgid % nig) % gsz); u.pn = (wgid % nig) / gsz; return true;
    }
    __device__ __forceinline__ void a_ready(const Unit&) const {}
    __device__ __forceinline__ void done(const Unit&) const {}
};


template <class Epi, class Sched, bool ALIGN_EPI = false, bool SP2 = false>
__device__ __forceinline__ void gemm_phase(PG8_LAS unsigned char* lds, const Gemm g, const Sched& S, const Epi& E) {
    const int tid = threadIdx.x, wid = __builtin_amdgcn_readfirstlane(tid >> 6), lane = tid & 63, wr = wid >> 2, wc = wid & 3, fr = lane & 15, fq = lane >> 4;
    const int K = g.K, nt = K / BK;
    unsigned voffA[2], voffB[2];
#pragma unroll
    for (int i = 0; i < 2; ++i) { int R, C; stage_rc(tid * 16 + i * 8192, R, C); const int Rb = Epi::PERM ? ((R & ~31) + perm32(R & 31)) : R;
        voffA[i] = (unsigned)(R * K + C) * 2u; voffB[i] = (unsigned)(Rb * K + C) * 2u; }
    const size_t kstep = (size_t)(BK * 2);
    const size_t hstep = (size_t)HALF * K * 2;
    const size_t tstep = 2 * hstep;
    const unsigned ldsw = (unsigned)wid * 1024u;
    const int aoff = lds_byte(wr * 64 + fr, fq * 8), boff = lds_byte(wc * 32 + fr, fq * 8);
#define PG8_SA(b, h) (((b) * 2 + (h)) * HTB)
#define PG8_SB(b, h) ((4 + (b) * 2 + (h)) * HTB)
#define PG8_STAGE(bufoff, gbase, voff) do { _Pragma("unroll") for (int _i = 0; _i < 2; ++_i) \
        __builtin_amdgcn_global_load_lds((const unsigned*)((const char*)(gbase) + (voff)[_i]), (PG8_LAS unsigned*)(lds + (bufoff) + ldsw + _i * 8192), 16, 0, 0); } while (0)
#define PG8_LDA(dst, b, h) do { _Pragma("unroll") for (int m = 0; m < 4; ++m) _Pragma("unroll") for (int k = 0; k < 2; ++k) dst[m][k] = *(const PG8_LAS bf16x8*)(lds + PG8_SA(b, h) + aoff + m * 2048 + k * 1024); } while (0)
#define PG8_LDB(dst, b, h) do { _Pragma("unroll") for (int n = 0; n < 2; ++n) _Pragma("unroll") for (int k = 0; k < 2; ++k) dst[n][k] = *(const PG8_LAS bf16x8*)(lds + PG8_SB(b, h) + boff + n * 2048 + k * 1024); } while (0)
#define PG8_MMA(ai, bj, At, Bt) do { __builtin_amdgcn_s_setprio(1); _Pragma("unroll") for (int m = 0; m < 4; ++m) _Pragma("unroll") for (int n = 0; n < 2; ++n) _Pragma("unroll") for (int k = 0; k < 2; ++k) \
        acc[ai][bj][m][n] = __builtin_amdgcn_mfma_f32_16x16x32_bf16(Bt[n][k], At[m][k], acc[ai][bj][m][n], 0, 0, 0); __builtin_amdgcn_s_setprio(0); } while (0)
#define PG8_WAIT_V(n) asm volatile("s_waitcnt vmcnt(" #n ")" ::: "memory")
#define PG8_WAIT_L(n) asm volatile("s_waitcnt lgkmcnt(" #n ")" ::: "memory")
#define PG8_BAR __builtin_amdgcn_s_barrier()
#define PG8_SCHED __builtin_amdgcn_sched_barrier(0)
    Unit cur, nxt; int ui = 0;
    if (!S.next(0, cur)) return;
    f32x4 acc[2][2][4][2];
#pragma unroll
    for (int a = 0; a < 2; ++a)
#pragma unroll
        for (int b = 0; b < 2; ++b)
#pragma unroll
            for (int m = 0; m < 4; ++m)
#pragma unroll
                for (int n = 0; n < 2; ++n) acc[a][b][m][n] = (f32x4){0.f, 0.f, 0.f, 0.f};
    bf16x8 At[4][2], B0[2][2], B1[2][2];
    const char* cA = (const char*)g.A + (size_t)cur.pm * tstep; const char* cB = (const char*)g.Bt + (size_t)cur.pn * tstep;
    S.a_ready(cur);
    if constexpr (SP2) {
        PG8_STAGE(PG8_SB(0, 0), cB, voffB); PG8_STAGE(PG8_SB(0, 1), cB + hstep, voffB); PG8_STAGE(PG8_SA(0, 0), cA, voffA); PG8_STAGE(PG8_SA(0, 1), cA + hstep, voffA);
        if (wr == 1) PG8_BAR;
        PG8_WAIT_V(2); PG8_BAR;
        PG8_STAGE(PG8_SB(1, 0), cB + kstep, voffB); PG8_STAGE(PG8_SA(1, 0), cA + kstep, voffA); PG8_STAGE(PG8_SB(1, 1), cB + hstep + kstep, voffB);
        PG8_WAIT_V(6); PG8_BAR;
    } else {
        PG8_STAGE(PG8_SB(0, 0), cB, voffB); PG8_STAGE(PG8_SA(0, 0), cA, voffA); PG8_STAGE(PG8_SB(0, 1), cB + hstep, voffB); PG8_STAGE(PG8_SA(0, 1), cA + hstep, voffA);
        if (wr == 1) PG8_BAR;
        PG8_WAIT_V(4); PG8_BAR;
        PG8_STAGE(PG8_SB(1, 0), cB + kstep, voffB); PG8_STAGE(PG8_SA(1, 0), cA + kstep, voffA); PG8_STAGE(PG8_SB(1, 1), cB + hstep + kstep, voffB);
        PG8_WAIT_V(6); PG8_BAR;
    }
    for (;;) {
        const bool has_next = S.next(ui + 1, nxt);
        const char* nA = has_next ? (const char*)g.A + (size_t)nxt.pm * tstep : cA; const char* nB = has_next ? (const char*)g.Bt + (size_t)nxt.pn * tstep : cB;
#pragma unroll 1
        for (int t = 0; t < nt; t += 2) {
            const bool last = (t == nt - 2);
            const char* a1 = cA + (size_t)(t + 1) * kstep;
            const char* a2 = last ? nA : cA + (size_t)(t + 2) * kstep; const char* b2 = last ? nB : cB + (size_t)(t + 2) * kstep;
            const char* a3 = a2 + kstep; const char* b3 = b2 + kstep;
            if (last && has_next) S.a_ready(nxt);
            if constexpr (SP2) {
            PG8_LDB(B0, 0, 0); PG8_LDB(B1, 0, 1); PG8_SCHED; PG8_LDA(At, 0, 0); PG8_STAGE(PG8_SA(1, 1), a1 + hstep, voffA);
            PG8_WAIT_V(8); PG8_WAIT_L(0); PG8_BAR; PG8_MMA(0, 0, At, B0); PG8_MMA(0, 1, At, B1); PG8_BAR; PG8_SCHED;
            PG8_LDA(At, 0, 1); PG8_STAGE(PG8_SB(0, 0), b2, voffB); PG8_STAGE(PG8_SB(0, 1), b2 + hstep, voffB); PG8_STAGE(PG8_SA(0, 0), a2, voffA);
            PG8_WAIT_V(8); PG8_WAIT_L(0); PG8_BAR; PG8_MMA(1, 0, At, B0); PG8_MMA(1, 1, At, B1); PG8_BAR; PG8_SCHED;
            PG8_LDB(B0, 1, 0); PG8_LDB(B1, 1, 1); PG8_SCHED; PG8_LDA(At, 1, 0); PG8_STAGE(PG8_SA(0, 1), a2 + hstep, voffA);
            PG8_WAIT_V(8); PG8_WAIT_L(0); PG8_BAR; PG8_MMA(0, 0, At, B0); PG8_MMA(0, 1, At, B1); PG8_BAR; PG8_SCHED;
            PG8_LDA(At, 1, 1); PG8_STAGE(PG8_SB(1, 0), b3, voffB); PG8_STAGE(PG8_SB(1, 1), b3 + hstep, voffB); PG8_STAGE(PG8_SA(1, 0), a3, voffA);
            PG8_WAIT_V(8); PG8_WAIT_L(0); PG8_BAR; PG8_MMA(1, 0, At, B0); PG8_MMA(1, 1, At, B1); PG8_BAR; PG8_SCHED;
            } else {
            PG8_LDB(B0, 0, 0); PG8_SCHED; PG8_LDA(At, 0, 0); PG8_STAGE(PG8_SA(1, 1), a1 + hstep, voffA);
            PG8_WAIT_L(8); PG8_BAR; PG8_WAIT_L(0); PG8_MMA(0, 0, At, B0); PG8_BAR; PG8_SCHED;
            PG8_LDB(B1, 0, 1); PG8_STAGE(PG8_SB(0, 0), b2, voffB);
            PG8_BAR; PG8_WAIT_L(0); PG8_MMA(0, 1, At, B1); PG8_BAR;
            PG8_LDA(At, 0, 1); PG8_STAGE(PG8_SA(0, 0), a2, voffA);
            PG8_BAR; PG8_WAIT_L(0); PG8_MMA(1, 0, At, B0); PG8_BAR; PG8_SCHED;
            PG8_STAGE(PG8_SB(0, 1), b2 + hstep, voffB);
            PG8_WAIT_V(6); PG8_BAR; PG8_MMA(1, 1, At, B1); PG8_BAR;
            PG8_LDB(B0, 1, 0); PG8_SCHED; PG8_LDA(At, 1, 0); PG8_STAGE(PG8_SA(0, 1), a2 + hstep, voffA);
            PG8_WAIT_L(8); PG8_BAR; PG8_WAIT_L(0); PG8_MMA(0, 0, At, B0); PG8_BAR; PG8_SCHED;
            PG8_LDB(B1, 1, 1); PG8_STAGE(PG8_SB(1, 0), b3, voffB);
            PG8_BAR; PG8_WAIT_L(0); PG8_MMA(0, 1, At, B1); PG8_BAR;
            PG8_LDA(At, 1, 1); PG8_STAGE(PG8_SA(1, 0), a3, voffA);
            PG8_BAR; PG8_WAIT_L(0); PG8_MMA(1, 0, At, B0); PG8_BAR; PG8_SCHED;
            PG8_STAGE(PG8_SB(1, 1), b3 + hstep, voffB);
            PG8_WAIT_V(6); PG8_BAR; PG8_MMA(1, 1, At, B1); PG8_BAR;
            }
        }
        if constexpr (ALIGN_EPI) { if (wr == 0) PG8_BAR; }
        if constexpr (!Epi::AFTER_DRAIN) { E(acc, cur, wr, wc, fr, fq); S.done(cur); }
        if (!has_next) break;
#pragma unroll
        for (int a = 0; a < 2; ++a)
#pragma unroll
            for (int b = 0; b < 2; ++b)
#pragma unroll
                for (int m = 0; m < 4; ++m)
#pragma unroll
                    for (int n = 0; n < 2; ++n) acc[a][b][m][n] = (f32x4){0.f, 0.f, 0.f, 0.f};
        cur = nxt; cA = nA; cB = nB; ++ui;
        if constexpr (ALIGN_EPI) { if (wr == 1) PG8_BAR; }
    }
    PG8_WAIT_V(0);
    if constexpr (!ALIGN_EPI) { if (wr == 0) PG8_BAR; }
    PG8_BAR;
    if constexpr (Epi::AFTER_DRAIN) { E.fused(acc, cur, wr, wc, fr, fq, lds, wid, lane); S.done(cur); }
#undef PG8_SA
#undef PG8_SB
#undef PG8_STAGE
#undef PG8_LDA
#undef PG8_LDB
#undef PG8_MMA
#undef PG8_WAIT_V
#undef PG8_WAIT_L
#undef PG8_BAR
#undef PG8_SCHED
}
}

namespace pg8 {
struct UnitG : Unit { int e; };
template <class Epi, class Sched>
__device__ __forceinline__ void gemm_phase_g(PG8_LAS unsigned char* lds, const int K, const Sched& S, const Epi& E) {
    const int tid = threadIdx.x, wid = __builtin_amdgcn_readfirstlane(tid >> 6), lane = tid & 63, wr = wid >> 2, wc = wid & 3, fr = lane & 15, fq = lane >> 4;
    const int nt = K / BK;
    unsigned voffB[2];
#pragma unroll
    for (int i = 0; i < 2; ++i) { int R, C; stage_rc(tid * 16 + i * 8192, R, C); const int Rb = Epi::PERM ? ((R & ~31) + perm32(R & 31)) : R;
        voffB[i] = (unsigned)(Rb * K + C) * 2u; }
    const size_t kstep = (size_t)(BK * 2);
    const size_t hstep = (size_t)HALF * K * 2;
    const unsigned ldsw = (unsigned)wid * 1024u;
    const int aoff = lds_byte(wr * 64 + fr, fq * 8), boff = lds_byte(wc * 32 + fr, fq * 8);
#define PG8_SA(b, h) (((b) * 2 + (h)) * HTB)
#define PG8_SB(b, h) ((4 + (b) * 2 + (h)) * HTB)
#define PG8_STAGE(bufoff, gbase, voff) do { _Pragma("unroll") for (int _i = 0; _i < 2; ++_i) \
        __builtin_amdgcn_global_load_lds((const unsigned*)((const char*)(gbase) + (voff)[_i]), (PG8_LAS unsigned*)(lds + (bufoff) + ldsw + _i * 8192), 16, 0, 0); } while (0)
#define PG8_LDA(dst, b, h) do { _Pragma("unroll") for (int m = 0; m < 4; ++m) _Pragma("unroll") for (int k = 0; k < 2; ++k) dst[m][k] = *(const PG8_LAS bf16x8*)(lds + PG8_SA(b, h) + aoff + m * 2048 + k * 1024); } while (0)
#define PG8_LDB(dst, b, h) do { _Pragma("unroll") for (int n = 0; n < 2; ++n) _Pragma("unroll") for (int k = 0; k < 2; ++k) dst[n][k] = *(const PG8_LAS bf16x8*)(lds + PG8_SB(b, h) + boff + n * 2048 + k * 1024); } while (0)
#define PG8_MMA(ai, bj, At, Bt) do { __builtin_amdgcn_s_setprio(1); _Pragma("unroll") for (int m = 0; m < 4; ++m) _Pragma("unroll") for (int n = 0; n < 2; ++n) _Pragma("unroll") for (int k = 0; k < 2; ++k) \
        acc[ai][bj][m][n] = __builtin_amdgcn_mfma_f32_16x16x32_bf16(Bt[n][k], At[m][k], acc[ai][bj][m][n], 0, 0, 0); __builtin_amdgcn_s_setprio(0); } while (0)
#define PG8_WAIT_V(n) asm volatile("s_waitcnt vmcnt(" #n ")" ::: "memory")
#define PG8_WAIT_L(n) asm volatile("s_waitcnt lgkmcnt(" #n ")" ::: "memory")
#define PG8_BAR __builtin_amdgcn_s_barrier()
#define PG8_SCHED __builtin_amdgcn_sched_barrier(0)
    UnitG cur, nxt; int ui = 0;
    if (!S.next(0, cur)) return;
    f32x4 acc[2][2][4][2];
#pragma unroll
    for (int a = 0; a < 2; ++a)
#pragma unroll
        for (int b = 0; b < 2; ++b)
#pragma unroll
            for (int m = 0; m < 4; ++m)
#pragma unroll
                for (int n = 0; n < 2; ++n) acc[a][b][m][n] = (f32x4){0.f, 0.f, 0.f, 0.f};
    bf16x8 At[4][2], B0[2][2], B1[2][2];
    const char* cA = S.a_base(cur); const char* cB = S.b_base(cur);
    unsigned vA0[2], vA1[2];
#pragma unroll
    for (int i = 0; i < 2; ++i) { int R, C; stage_rc(tid * 16 + i * 8192, R, C); vA0[i] = S.a_voff(cur, R, C, 0); vA1[i] = S.a_voff(cur, R, C, 1); }
    PG8_STAGE(PG8_SB(0, 0), cB, voffB); PG8_STAGE(PG8_SB(0, 1), cB + hstep, voffB); PG8_STAGE(PG8_SA(0, 0), cA, vA0); PG8_STAGE(PG8_SA(0, 1), cA, vA1);
    if (wr == 1) PG8_BAR;
    PG8_WAIT_V(2); PG8_BAR;
    PG8_STAGE(PG8_SB(1, 0), cB + kstep, voffB); PG8_STAGE(PG8_SA(1, 0), cA + kstep, vA0); PG8_STAGE(PG8_SB(1, 1), cB + hstep + kstep, voffB);
    PG8_WAIT_V(6); PG8_BAR;
    for (;;) {
        const bool has_next = S.next(ui + 1, nxt);
        const char* nA = has_next ? S.a_base(nxt) : cA; const char* nB = has_next ? S.b_base(nxt) : cB;
#pragma unroll 1
        for (int t = 0; t < nt; t += 2) {
            const bool last = (t == nt - 2);
            const char* a1 = cA + (size_t)(t + 1) * kstep;
            const char* a2 = last ? nA : cA + (size_t)(t + 2) * kstep; const char* b2 = last ? nB : cB + (size_t)(t + 2) * kstep;
            const char* a3 = a2 + kstep; const char* b3 = b2 + kstep;
            unsigned sA0[2], sA1[2];
#pragma unroll
            for (int i = 0; i < 2; ++i) { sA0[i] = vA0[i]; sA1[i] = vA1[i]; }
            if (last && has_next) {
#pragma unroll
                for (int i = 0; i < 2; ++i) { int R, C; stage_rc(tid * 16 + i * 8192, R, C); sA0[i] = S.a_voff(nxt, R, C, 0); sA1[i] = S.a_voff(nxt, R, C, 1); }
            }
            PG8_LDB(B0, 0, 0); PG8_LDB(B1, 0, 1); PG8_SCHED; PG8_LDA(At, 0, 0); PG8_STAGE(PG8_SA(1, 1), a1, vA1);
            PG8_WAIT_V(8); PG8_WAIT_L(0); PG8_BAR; PG8_MMA(0, 0, At, B0); PG8_MMA(0, 1, At, B1); PG8_BAR; PG8_SCHED;
            PG8_LDA(At, 0, 1); PG8_STAGE(PG8_SB(0, 0), b2, voffB); PG8_STAGE(PG8_SB(0, 1), b2 + hstep, voffB); PG8_STAGE(PG8_SA(0, 0), a2, sA0);
            PG8_WAIT_V(8); PG8_WAIT_L(0); PG8_BAR; PG8_MMA(1, 0, At, B0); PG8_MMA(1, 1, At, B1); PG8_BAR; PG8_SCHED;
            PG8_LDB(B0, 1, 0); PG8_LDB(B1, 1, 1); PG8_SCHED; PG8_LDA(At, 1, 0); PG8_STAGE(PG8_SA(0, 1), a2, sA1);
            PG8_WAIT_V(8); PG8_WAIT_L(0); PG8_BAR; PG8_MMA(0, 0, At, B0); PG8_MMA(0, 1, At, B1); PG8_BAR; PG8_SCHED;
            PG8_LDA(At, 1, 1); PG8_STAGE(PG8_SB(1, 0), b3, voffB); PG8_STAGE(PG8_SB(1, 1), b3 + hstep, voffB); PG8_STAGE(PG8_SA(1, 0), a3, sA0);
            PG8_WAIT_V(8); PG8_WAIT_L(0); PG8_BAR; PG8_MMA(1, 0, At, B0); PG8_MMA(1, 1, At, B1); PG8_BAR; PG8_SCHED;
        }
        if (wr == 0) PG8_BAR;
        E(acc, cur, wr, wc, fr, fq);
        if (!has_next) break;
#pragma unroll
        for (int a = 0; a < 2; ++a)
#pragma unroll
            for (int b = 0; b < 2; ++b)
#pragma unroll
                for (int m = 0; m < 4; ++m)
#pragma unroll
                    for (int n = 0; n < 2; ++n) acc[a][b][m][n] = (f32x4){0.f, 0.f, 0.f, 0.f};
        cur = nxt; cA = nA; cB = nB; ++ui;
#pragma unroll
        for (int i = 0; i < 2; ++i) { int R, C; stage_rc(tid * 16 + i * 8192, R, C); vA0[i] = S.a_voff(cur, R, C, 0); vA1[i] = S.a_voff(cur, R, C, 1); }
        if (wr == 1) PG8_BAR;
    }
    PG8_WAIT_V(0);
    PG8_BAR;
#undef PG8_SA
#undef PG8_SB
#undef PG8_STAGE
#undef PG8_LDA
#undef PG8_LDB
#undef PG8_MMA
#undef PG8_WAIT_V
#undef PG8_WAIT_L
#undef PG8_BAR
#undef PG8_SCHED
}
}

namespace pg8 {
typedef unsigned u32x2 __attribute__((ext_vector_type(2)));
typedef __bf16 bf16x2_t __attribute__((ext_vector_type(2)));
typedef float f32x2_t __attribute__((ext_vector_type(2)));
__device__ __forceinline__ unsigned cvt_pk_bf16(float lo, float hi) { f32x2_t v = {lo, hi}; bf16x2_t r = __builtin_convertvector(v, bf16x2_t); return __builtin_bit_cast(unsigned, r); }
__device__ __forceinline__ float fast_sigmoid(float x) { return __builtin_amdgcn_rcpf(1.f + __builtin_amdgcn_exp2f(-1.4426950408889634f * x)); }
__device__ __forceinline__ void store8(bf16_t* p, const f32x4& v0, const f32x4& v1) {
    u32x4 w; w.x = cvt_pk_bf16(v0[0], v0[1]); w.y = cvt_pk_bf16(v0[2], v0[3]); w.z = cvt_pk_bf16(v1[0], v1[1]); w.w = cvt_pk_bf16(v1[2], v1[3]); *(u32x4*)p = w;
}
__device__ __forceinline__ float log2_gamma(int h) { return h == 0 ? -0.045803689613124944f : (h == 1 ? -0.022720076500083580f : (h == 2 ? -0.011315313227834146f : -0.005646563141142063f)); }

struct EpiProj {
    static constexpr bool PERM = true, AFTER_DRAIN = false;
    bf16_t *upool, *q, *k, *v, *g, *xq, *gates; const float* cs;
    template <int KIND>
    __device__ __forceinline__ void run(const f32x4 (&acc)[2][2][4][2], bf16_t* base, int ld, int colt, int pm, int hbase, int wr, int wc, int fr, int fq) const {
        const int row0 = pm * BM + wr * 64 + fr, lc = wc * 32 + 8 * fq;
#pragma unroll
        for (int ai = 0; ai < 2; ++ai)
#pragma unroll
            for (int m = 0; m < 4; ++m) {
                const int row = row0 + ai * HALF + m * 16;
                bf16_t* rowp = base + (size_t)row * ld + colt + lc;
                f32x4 c0, c1;
                if (KIND >= 4) { const f32x4* cp = (const f32x4*)(cs + ((size_t)row * 64 + (lc >> 1)) * 2); c0 = cp[0]; c1 = cp[1]; }
#pragma unroll
                for (int bj = 0; bj < 2; ++bj) {
                    f32x4 v0 = acc[ai][bj][m][0], v1 = acc[ai][bj][m][1];
                    if (KIND == 1) { for (int e = 0; e < 4; ++e) { v0[e] = v0[e] * fast_sigmoid(v0[e]); v1[e] = v1[e] * fast_sigmoid(v1[e]); } }
                    else if (KIND == 2) { v0 = v0 * 0.08838834764831845f; v1 = v1 * 0.08838834764831845f; }
                    else if (KIND == 3) { for (int e = 0; e < 4; ++e) { v0[e] = fast_sigmoid(v0[e]); v1[e] = fast_sigmoid(v1[e]); } }
                    else if (KIND >= 4) {
                        const float cpos = (float)(row & (CH - 1)), l2g = log2_gamma(hbase + bj);
                        const float sc = (KIND == 4) ? __builtin_amdgcn_exp2f(cpos * l2g) : 0.08838834764831845f * __builtin_amdgcn_exp2f(-cpos * l2g);
                        f32x4 r0, r1;
                        r0[0] = (v0[0] * c0[0] - v0[1] * c0[1]) * sc; r0[1] = (v0[1] * c0[0] + v0[0] * c0[1]) * sc;
                        r0[2] = (v0[2] * c0[2] - v0[3] * c0[3]) * sc; r0[3] = (v0[3] * c0[2] + v0[2] * c0[3]) * sc;
                        r1[0] = (v1[0] * c1[0] - v1[1] * c1[1]) * sc; r1[1] = (v1[1] * c1[0] + v1[0] * c1[1]) * sc;
                        r1[2] = (v1[2] * c1[2] - v1[3] * c1[3]) * sc; r1[3] = (v1[3] * c1[2] + v1[2] * c1[3]) * sc;
                        v0 = r0; v1 = r1;
                    }
                    store8(rowp + bj * HALF, v0, v1);
                }
            }
    }
    __device__ __forceinline__ void operator()(const f32x4 (&acc)[2][2][4][2], const Unit& u, int wr, int wc, int fr, int fq) const {
        const int pn = u.pn;
        if (pn < 2) run<0>(acc, upool, 512, pn * 256, u.pm, 0, wr, wc, fr, fq);
        else if (pn < 4) run<4>(acc, q, 512, (pn - 2) * 256, u.pm, (pn - 2) * 2, wr, wc, fr, fq);
        else if (pn < 6) run<5>(acc, k, 512, (pn - 4) * 256, u.pm, (pn - 4) * 2, wr, wc, fr, fq);
        else if (pn < 10) run<0>(acc, v, 1024, (pn - 6) * 256, u.pm, 0, wr, wc, fr, fq);
        else if (pn < 14) run<1>(acc, g, 1024, (pn - 10) * 256, u.pm, 0, wr, wc, fr, fq);
        else if (pn < 16) run<2>(acc, xq, 512, (pn - 14) * 256, u.pm, 0, wr, wc, fr, fq);
        else run<3>(acc, gates, 3072, (pn - 16) * 256, u.pm, 0, wr, wc, fr, fq);
    }
};
}

namespace pg8 {
struct EpiMemKV {
    static constexpr bool PERM = true, AFTER_DRAIN = false;
    bf16_t *mk, *mv;
    __device__ __forceinline__ void operator()(const f32x4 (&acc)[2][2][4][2], const Unit& u, int wr, int wc, int fr, int fq) const {
        bf16_t* base = u.pn < 2 ? mk : mv; const int colt = (u.pn & 1) * 256;
        const int row0 = u.pm * BM + wr * 64 + fr, lc = wc * 32 + 8 * fq;
#pragma unroll
        for (int ai = 0; ai < 2; ++ai)
#pragma unroll
            for (int m = 0; m < 4; ++m) { bf16_t* rowp = base + (size_t)(row0 + ai * HALF + m * 16) * 512 + colt + lc;
#pragma unroll
                for (int bj = 0; bj < 2; ++bj) store8(rowp + bj * HALF, acc[ai][bj][m][0], acc[ai][bj][m][1]); }
    }
};
struct EpiPoolMap {
    static constexpr bool PERM = true, AFTER_DRAIN = false;
    bf16_t* ypool; const float* scale;
    __device__ __forceinline__ void operator()(const f32x4 (&acc)[2][2][4][2], const Unit& u, int wr, int wc, int fr, int fq) const {
        const int row0 = u.pm * BM + wr * 64 + fr, col0 = u.pn * 256 + wc * 32 + 8 * fq;
        f32x4 s[2][2];
#pragma unroll
        for (int bj = 0; bj < 2; ++bj) { s[bj][0] = *(const f32x4*)(scale + col0 + bj * HALF); s[bj][1] = *(const f32x4*)(scale + col0 + bj * HALF + 4); }
#pragma unroll
        for (int ai = 0; ai < 2; ++ai)
#pragma unroll
            for (int m = 0; m < 4; ++m) { bf16_t* rowp = ypool + (size_t)(row0 + ai * HALF + m * 16) * 512 + col0;
#pragma unroll
                for (int bj = 0; bj < 2; ++bj) store8(rowp + bj * HALF, acc[ai][bj][m][0] * s[bj][0], acc[ai][bj][m][1] * s[bj][1]); }
    }
};
__device__ __forceinline__ f32x4 bf4_to_f32(unsigned lo, unsigned hi) {
    f32x4 r; r[0] = __uint_as_float(lo << 16); r[1] = __uint_as_float(lo & 0xffff0000u); r[2] = __uint_as_float(hi << 16); r[3] = __uint_as_float(hi & 0xffff0000u); return r;
}
template <bool FIRST> struct EpiGate {
    static constexpr bool PERM = true, AFTER_DRAIN = false;
    bf16_t* merged; const bf16_t* gates; int gofs;
    __device__ __forceinline__ void operator()(const f32x4 (&acc)[2][2][4][2], const Unit& u, int wr, int wc, int fr, int fq) const {
        const int row0 = u.pm * BM + wr * 64 + fr, col0 = u.pn * 256 + wc * 32 + 8 * fq;
#pragma unroll
        for (int ai = 0; ai < 2; ++ai)
#pragma unroll
            for (int m = 0; m < 4; ++m) { const size_t row = (size_t)(row0 + ai * HALF + m * 16);
#pragma unroll
                for (int bj = 0; bj < 2; ++bj) { const int c = col0 + bj * HALF;
                    const u32x4 gw = *(const u32x4*)(gates + row * 3072 + gofs + c);
                    f32x4 v0 = acc[ai][bj][m][0] * bf4_to_f32(gw.x, gw.y), v1 = acc[ai][bj][m][1] * bf4_to_f32(gw.z, gw.w);
                    bf16_t* mp = merged + row * 1024 + c;
                    if (!FIRST) { const u32x4 pw = *(const u32x4*)mp; v0 += bf4_to_f32(pw.x, pw.y); v1 += bf4_to_f32(pw.z, pw.w); }
                    store8(mp, v0, v1); }
                asm volatile("" ::: "memory"); }
    }
};
struct EpiResid {
    static constexpr bool PERM = true, AFTER_DRAIN = false;
    float* h; const float* x;
    __device__ __forceinline__ void operator()(const f32x4 (&acc)[2][2][4][2], const Unit& u, int wr, int wc, int fr, int fq) const {
        const int row0 = u.pm * BM + wr * 64 + fr, col0 = u.pn * 256 + wc * 32 + 8 * fq;
#pragma unroll
        for (int ai = 0; ai < 2; ++ai)
#pragma unroll
            for (int m = 0; m < 4; ++m) { const size_t o = (size_t)(row0 + ai * HALF + m * 16) * 1024 + col0;
#pragma unroll
                for (int bj = 0; bj < 2; ++bj) { const float* xp = x + o + bj * HALF; float* hp = h + o + bj * HALF;
                    *(f32x4*)hp = *(const f32x4*)xp * ALPHA + acc[ai][bj][m][0]; *(f32x4*)(hp + 4) = *(const f32x4*)(xp + 4) * ALPHA + acc[ai][bj][m][1]; }
                asm volatile("" ::: "memory"); }
    }
};
}

#define GAS __attribute__((address_space(1)))
#define LAS __attribute__((address_space(3)))
typedef unsigned v4u __attribute__((ext_vector_type(4)));
typedef unsigned v2u __attribute__((ext_vector_type(2)));
typedef float f32x4 __attribute__((ext_vector_type(4)));
typedef float f32x16 __attribute__((ext_vector_type(16)));
typedef short bf16x8 __attribute__((ext_vector_type(8)));
typedef short bf16x4 __attribute__((ext_vector_type(4)));
#define LDS_WAIT() asm volatile("s_waitcnt lgkmcnt(0)" ::: "memory")
#define VM_WAIT() asm volatile("s_waitcnt vmcnt(0)" ::: "memory")
__device__ __forceinline__ unsigned pk2(float lo, float hi) { return pg8::cvt_pk_bf16(lo, hi); }
constexpr int NWAVES = 8, NTHREADS = 512;
constexpr int RING_BYTES = 131072;
constexpr int MISC_OFF = 163840 - 256;
constexpr int LDS_BYTES = 163840;

#define XB_TMO      128
#define XB_XCNT(j)  (256  + 64 * (j))
#define XB_XSUB(j)  (1280 + 64 * (j))
#define XB_XGEN(j)  (2304 + 64 * (j))
#define XB_TOP      3328
#define XB_TOPGEN   3392
#define XCD_BAR_WORDS 3456
#define XB_SPIN_CAP (1u << 18)

__device__ __forceinline__ unsigned xb_ld(unsigned* p)              { return __hip_atomic_load(p, __ATOMIC_RELAXED, __HIP_MEMORY_SCOPE_AGENT); }
__device__ __forceinline__ unsigned xb_add(unsigned* p, unsigned v) { return __hip_atomic_fetch_add(p, v, __ATOMIC_RELAXED, __HIP_MEMORY_SCOPE_AGENT); }
__device__ __forceinline__ unsigned xb_xcc_id() { return (unsigned)__builtin_amdgcn_s_getreg((3 << 11) | 20) & 0xFu; }
#define XB_SPIN(cond, bar) do { unsigned _sp = 0; while (cond) { __builtin_amdgcn_s_sleep(1); \
    if ((++_sp & 255u) == 0u) { if (xb_ld(&(bar)[XB_TMO])) break; if (_sp > XB_SPIN_CAP) { atomicAdd(&(bar)[XB_TMO], 1u); break; } } } } while (0)

struct XcdBarrier {
    unsigned* bar; unsigned x;
    volatile LAS unsigned* st;
};

__device__ __forceinline__ XcdBarrier xcd_barrier_post(unsigned* bar, volatile LAS unsigned* st) {
    XcdBarrier b; b.bar = bar; b.x = xb_xcc_id(); b.st = st;
    if (threadIdx.x == 0) (void)xb_add(&bar[XB_XCNT(b.x)], 1u);
    return b;
}
__device__ __forceinline__ void xcd_barrier_complete(unsigned* bar, unsigned x, unsigned& nloc, unsigned& nx) {
    const unsigned G = gridDim.x * gridDim.y * gridDim.z;
    unsigned sum, cnt, mine, sp = 0u;
    for (;;) {
        sum = 0u; cnt = 0u; mine = 0u;
#pragma unroll
        for (unsigned j = 0; j < 16; ++j) { const unsigned c = xb_ld(&bar[XB_XCNT(j)]); sum += c; cnt += (c > 0u) ? 1u : 0u; mine = (j == x) ? c : mine; }
        if (sum == G) break;
        __builtin_amdgcn_s_sleep(1);
        if ((++sp & 255u) == 0u) { if (xb_ld(&bar[XB_TMO])) break; if (sp > XB_SPIN_CAP) { atomicAdd(&bar[XB_TMO], 1u); break; } }
    }
    nloc = mine > 0u ? mine : 1u; nx = cnt > 0u ? cnt : 1u;
}

__device__ __forceinline__ void xcd_barrier(const XcdBarrier& b) {
    asm volatile("s_waitcnt vmcnt(0)" ::: "memory");
    __syncthreads();
    if (threadIdx.x == 0) {
        unsigned* bar = b.bar;
        __builtin_amdgcn_s_waitcnt(0);
        unsigned nloc = b.st[0], nx = b.st[1];
        if (nloc == 0u) { xcd_barrier_complete(bar, b.x, nloc, nx); b.st[0] = nloc; b.st[1] = nx; }
        const unsigned old = xb_add(&bar[XB_XSUB(b.x)], 1u);
        const unsigned gen = old / nloc;
        if (old + 1u == (gen + 1u) * nloc) {
            __builtin_amdgcn_fence(__ATOMIC_RELEASE, "agent");
            asm volatile("s_waitcnt vmcnt(0)" ::: "memory");
            const unsigned og = xb_add(&bar[XB_TOP], 1u);
            const unsigned tg = og / nx;
            if (og + 1u == (tg + 1u) * nx) xb_add(&bar[XB_TOPGEN], 1u);
            else XB_SPIN(xb_ld(&bar[XB_TOPGEN]) == tg, bar);
            __builtin_amdgcn_fence(__ATOMIC_ACQUIRE, "agent");
            xb_add(&bar[XB_XGEN(b.x)], 1u);
            asm volatile("s_waitcnt vmcnt(0)" ::: "memory");
        } else {
            XB_SPIN(xb_ld(&bar[XB_XGEN(b.x)]) == gen, bar);
            __builtin_amdgcn_fence(__ATOMIC_ACQUIRE, "agent");
            asm volatile("s_waitcnt vmcnt(0)" ::: "memory");
        }
    }
    __syncthreads();
}

struct Args { const void* in[23]; float* out; unsigned char* ws; int ph_lo, ph_hi, li, pad; };
struct Ctx {
    LAS unsigned char* lds; int tid, lane, wave, G, vcu;
};
template <class F>
__device__ __forceinline__ void transpose_item(F colf, int ldw, bf16_t* WT, int K, int kb, int nb, LAS float* scr, int lane) {
    const int k0 = 64 * kb, n0 = 32 * nb;
    const float* cp = colf(n0 + (lane & 31)) + (size_t)k0 * ldw;
#pragma unroll 8
    for (int i = 0; i < 32; ++i) { const int kk = 2 * i + (lane >> 5); scr[kk * 33 + (lane & 31)] = cp[(size_t)kk * ldw]; }
    LDS_WAIT(); asm volatile("" ::: "memory");
    const int c = lane & 7;
#pragma unroll
    for (int j = 0; j < 4; ++j) { const int n = (lane >> 3) + 8 * j; const LAS float* s = scr + (8 * c) * 33 + n;
        v4u o; o.x = pk2(s[0 * 33], s[1 * 33]); o.y = pk2(s[2 * 33], s[3 * 33]); o.z = pk2(s[4 * 33], s[5 * 33]); o.w = pk2(s[6 * 33], s[7 * 33]);
        *(v4u*)(WT + (size_t)(n0 + n) * K + k0 + 8 * c) = o; }
    LDS_WAIT(); asm volatile("" ::: "memory");
}
template <class F>
__device__ __forceinline__ void transpose_item64(F colf, int ldw, bf16_t* WT, int K, int kb, int nb, LAS float* scr, int lane) {
    const int k0 = 64 * kb, n0 = 64 * nb, c4 = lane & 15;
    const float* cp = colf(n0 + 4 * c4) + (size_t)k0 * ldw;
#pragma unroll 8
    for (int i = 0; i < 16; ++i) { const int kk = 4 * i + (lane >> 4); const f32x4 v = *(const f32x4*)(cp + (size_t)kk * ldw);
        LAS float* s = scr + kk * 65 + 4 * c4; s[0] = v[0]; s[1] = v[1]; s[2] = v[2]; s[3] = v[3]; }
    LDS_WAIT(); asm volatile("" ::: "memory");
    const int c = lane & 7;
#pragma unroll
    for (int j = 0; j < 8; ++j) { const int n = (lane >> 3) + 8 * j; const LAS float* s = scr + (8 * c) * 65 + n;
        v4u o; o.x = pk2(s[0 * 65], s[1 * 65]); o.y = pk2(s[2 * 65], s[3 * 65]); o.z = pk2(s[4 * 65], s[5 * 65]); o.w = pk2(s[6 * 65], s[7 * 65]);
        *(v4u*)(WT + (size_t)(n0 + n) * K + k0 + 8 * c) = o; }
    LDS_WAIT(); asm volatile("" ::: "memory");
}
struct ColPlain { const float* w; __device__ __forceinline__ const float* operator()(int n) const { return w + n; } };
struct ColWin {
    const float* w;
    __device__ __forceinline__ const float* operator()(int n) const {
        int src = n;
        if (n >= 512 && n < 1536) { const int r = (n - 512) & 511, sec = (n - 512) >> 9, hh = r >> 7, p = r & 127; src = 512 + sec * 512 + hh * 128 + (p >> 1) + 64 * (p & 1); }
        return w + src;
    }
};
__device__ __forceinline__ void f32_to_bf16_range(const float* in, bf16_t* out, size_t n4, size_t gtid, size_t nthr) {
    for (size_t i = gtid; i < n4; i += nthr) { const f32x4 v = ((const f32x4*)in)[i]; v2u o; o.x = pk2(v[0], v[1]); o.y = pk2(v[2], v[3]); ((v2u*)out)[i] = o; }
}
__device__ __forceinline__ void p0_prologue(const Ctx& C, const Args& a) {
    const float* x = (const float*)a.in[0]; const float* mem = (const float*)a.in[1]; const int* positions = (const int*)a.in[2];
    const float* w_in = (const float*)a.in[3]; const float* w_pool_grp = (const float*)a.in[4]; const float* w_mem_kv = (const float*)a.in[7];
    const float* w_br_pool = (const float*)a.in[8]; const float* w_br_ret = (const float*)a.in[9]; const float* w_br_xa = (const float*)a.in[10]; const float* w_out = (const float*)a.in[11];
    unsigned char* dout = (unsigned char*)a.out; unsigned char* ws = a.ws;
    LAS float* scr = (LAS float*)(C.lds + C.wave * 16640);
    const int gw = C.vcu * NWAVES + C.wave, NGW = C.G * NWAVES;
    constexpr int I_WA = 16 * 8, I_WQK = 16 * 32, I_WB = 16 * 88, I_WMEM = 16 * 16, I_WP = 8 * 16, I_WR = 16 * 16, I_WX = 8 * 16, I_WO = 16 * 16;
    constexpr int NITEMS = I_WA + I_WQK + I_WB + I_WMEM + I_WP + I_WR + I_WX + I_WO;
    for (int it = gw; it < NITEMS; it += NGW) {
        int r = it;
        if (r < I_WA) { transpose_item64(ColPlain{w_in}, NIN, (bf16_t*)(dout + DO_WINT), 1024, r / 8, r % 8, scr, C.lane); continue; } r -= I_WA;
        if (r < I_WQK) { transpose_item(ColWin{w_in}, NIN, (bf16_t*)(dout + DO_WINT), 1024, r / 32, 16 + r % 32, scr, C.lane); continue; } r -= I_WQK;
        if (r < I_WB) { transpose_item64(ColPlain{w_in}, NIN, (bf16_t*)(dout + DO_WINT), 1024, r / 88, 24 + r % 88, scr, C.lane); continue; } r -= I_WB;
        if (r < I_WMEM) { transpose_item64(ColPlain{w_mem_kv}, 1024, (bf16_t*)(ws + WS_WMEMT), 1024, r / 16, r % 16, scr, C.lane); continue; } r -= I_WMEM;
        if (r < I_WP) { transpose_item64(ColPlain{w_br_pool}, 1024, (bf16_t*)(ws + WS_WPT), 512, r / 16, r % 16, scr, C.lane); continue; } r -= I_WP;
        if (r < I_WR) { transpose_item64(ColPlain{w_br_ret}, 1024, (bf16_t*)(ws + WS_WRT), 1024, r / 16, r % 16, scr, C.lane); continue; } r -= I_WR;
        if (r < I_WX) { transpose_item64(ColPlain{w_br_xa}, 1024, (bf16_t*)(ws + WS_WXT), 512, r / 16, r % 16, scr, C.lane); continue; } r -= I_WX;
        transpose_item64(ColPlain{w_out}, 1024, (bf16_t*)(ws + WS_WOUTT), 1024, r / 16, r % 16, scr, C.lane);
    }
    const size_t gtid = (size_t)C.vcu * NTHREADS + C.tid, nthr = (size_t)C.G * NTHREADS;
    f32_to_bf16_range(x, (bf16_t*)(dout + DO_XB), (size_t)T * 1024 / 4, gtid, nthr);
    f32_to_bf16_range(mem, (bf16_t*)(ws + WS_MEMB), (size_t)BATCH * MEML * 1024 / 4, gtid, nthr);
    { bf16_t* wbd = (bf16_t*)(ws + WS_WPOOLBD);
      for (size_t i = gtid; i < 512 * 512; i += nthr) { const int n = (int)(i >> 9), k = (int)(i & 511);
          wbd[i] = ((n >> 7) == (k >> 7)) ? f2bf(w_pool_grp[((size_t)(n >> 7) * 128 + (k & 127)) * 128 + (n & 127)]) : (bf16_t)0; } }
    { float* cs = (float*)(dout + DO_CS); const int j = (int)(gtid & 63);
      const double invf = (double)(float)pow(10000.0, -(double)j / 64.0);
      for (size_t i = gtid; i < (size_t)T * 64; i += nthr) { const int t = (int)(i >> 6); const double ang = (double)positions[t] * invf;
          cs[2 * i] = (float)cos(ang); cs[2 * i + 1] = (float)sin(ang); } }
}

namespace pg8 {
template <bool GATHER> struct MoeSched {
    const PG8_LAS int* base;
    const int* cnt; const int* lists;
    const char* A; const char* Bt; size_t b_estride;
    int K, NP, G, c;
    __device__ __forceinline__ bool next(int i, UnitG& u) const {
        const int ntr = base[32] >> 8, L = i * G + c;
        if (L >= ntr * NP) return false;
        const int rt = L / NP;
        u.pm = rt; u.pn = L - rt * NP; u.e = base[40 + rt]; return true;
    }
    __device__ __forceinline__ const char* a_base(const UnitG& u) const { return GATHER ? A : A + (size_t)u.pm * 256 * K * 2; }
    __device__ __forceinline__ const char* b_base(const UnitG& u) const { return Bt + (size_t)u.e * b_estride + (size_t)u.pn * 256 * K * 2; }
    __device__ __forceinline__ unsigned a_voff(const UnitG& u, int R, int C, int half) const {
        if (!GATHER) return (unsigned)((half * 128 + R) * K + C) * 2u;
        const int slot = u.pm * 256 + half * 128 + R - base[u.e], n = cnt[u.e];
        const int tok = lists[(size_t)u.e * T + (slot < n ? slot : 0)];
        return (unsigned)(tok * K + C) * 2u;
    }
};
struct MoeOrder {
    const PG8_LAS int* base; int NP, G, c;
    __device__ __forceinline__ bool next(int i, Unit& u) const {
        const int ntr = base[32] >> 8, L = i * G + c;
        if (L >= ntr * NP) return false;
        const int rt = L / NP, e = base[40 + rt];
        u.pm = rt; u.pn = e * NP + (L - rt * NP); return true;
    }
    __device__ __forceinline__ void a_ready(const Unit&) const {}
    __device__ __forceinline__ void done(const Unit&) const {}
};
struct EpiMoeAct {
    static constexpr bool PERM = true, AFTER_DRAIN = false;
    bf16_t* act;
    __device__ __forceinline__ void operator()(const f32x4 (&acc)[2][2][4][2], const Unit& u, int wr, int wc, int fr, int fq) const {
        const int row0 = u.pm * BM + wr * 64 + fr, f0 = u.pn * 128 + wc * 32 + 8 * fq;
#pragma unroll
        for (int ai = 0; ai < 2; ++ai)
#pragma unroll
            for (int m = 0; m < 4; ++m) { f32x4 o0, o1;
#pragma unroll
                for (int e = 0; e < 4; ++e) { const float g0 = acc[ai][0][m][0][e], g1 = acc[ai][0][m][1][e];
                    o0[e] = g0 * fast_sigmoid(g0) * acc[ai][1][m][0][e]; o1[e] = g1 * fast_sigmoid(g1) * acc[ai][1][m][1][e]; }
                store8(act + (size_t)(row0 + ai * HALF + m * 16) * 256 + f0, o0, o1); }
    }
};
struct EpiMoeY {
    static constexpr bool PERM = true, AFTER_DRAIN = false;
    bf16_t* y;
    __device__ __forceinline__ void operator()(const f32x4 (&acc)[2][2][4][2], const Unit& u, int wr, int wc, int fr, int fq) const {
        const int row0 = u.pm * BM + wr * 64 + fr, col0 = (u.pn & 3) * 256 + wc * 32 + 8 * fq;
#pragma unroll
        for (int ai = 0; ai < 2; ++ai)
#pragma unroll
            for (int m = 0; m < 4; ++m) { bf16_t* rowp = y + (size_t)(row0 + ai * HALF + m * 16) * 1024 + col0;
#pragma unroll
                for (int bj = 0; bj < 2; ++bj) store8(rowp + bj * HALF, acc[ai][bj][m][0], acc[ai][bj][m][1]); }
    }
};
}
struct ColMoe1 {
    unsigned long long wg, delta;
    __device__ __forceinline__ const float* operator()(int n) const { const unsigned long long p = wg + (((n >> 7) & 1) ? delta : 0ull); return (const float*)p + (n >> 8) * 128 + (n & 127); }
};
__device__ __forceinline__ void moe_convert_weights(const Ctx& C, const Args& a) {
    const float* w_eg = (const float*)a.in[18]; const float* w_eu = (const float*)a.in[19]; const float* w_ed = (const float*)a.in[20];
    bf16_t* w1 = (bf16_t*)(a.ws + WS_MOEW1); bf16_t* w2 = (bf16_t*)(a.ws + WS_MOEW2);
    LAS float* scr = (LAS float*)(C.lds + C.wave * 16640);
    const int gw = C.vcu * NWAVES + C.wave, NGW = C.G * NWAVES;
    for (int it = gw; it < 6144; it += NGW) {
        if (it < 4096) { const int e = it >> 7, r = it & 127;
            transpose_item64(ColMoe1{(unsigned long long)(w_eg + (size_t)e * 262144), (unsigned long long)w_eu - (unsigned long long)w_eg}, 256, w1 + (size_t)e * 524288, 1024, r >> 3, r & 7, scr, C.lane); }
        else { const int r = it - 4096, e = r >> 6, rr = r & 63;
            transpose_item64(ColPlain{w_ed + (size_t)e * 262144}, 1024, w2 + (size_t)e * 262144, 256, rr >> 4, rr & 15, scr, C.lane); }
    }
}
__device__ __forceinline__ void compute_base(const Ctx& C, const int* cnt, LAS int* base) {
    if (C.wave == 0) {
        const int c = C.lane < 32 ? cnt[C.lane] : 0, p = (c + 255) & ~255; int incl = p;
#pragma unroll
        for (int o = 1; o < 32; o <<= 1) { const int t = __shfl_up(incl, o); if (C.lane >= o) incl += t; }
        if (C.lane < 32) base[C.lane] = incl - p;
        if (C.lane == 31) base[32] = incl;
    }
    __syncthreads();
    if (C.tid < 160) { const int r0 = C.tid << 8; int e = 0;
#pragma unroll 1
        for (int j = 1; j < 32; ++j) e = (base[j] <= r0) ? j : e;
        base[40 + C.tid] = e; }
    __syncthreads();
}

struct TokInfo { int e0, e1, s0, s1; float w0, w1; int pad0, pad1; };
#define DPP_ADD(v, ctrl) ((v) + __builtin_bit_cast(float, __builtin_amdgcn_mov_dpp(__builtin_bit_cast(int, (v)), (ctrl), 0xf, 0xf, true)))
__device__ __forceinline__ float wave_sum(float v) {
    v = DPP_ADD(v, 0xB1);
    v = DPP_ADD(v, 0x4E);
    v = DPP_ADD(v, 0x124);
    v = DPP_ADD(v, 0x128);
    const int b = __builtin_bit_cast(int, v);
    return (__builtin_bit_cast(float, __builtin_amdgcn_readlane(b, 0)) + __builtin_bit_cast(float, __builtin_amdgcn_readlane(b, 16)))
         + (__builtin_bit_cast(float, __builtin_amdgcn_readlane(b, 32)) + __builtin_bit_cast(float, __builtin_amdgcn_readlane(b, 48)));
}
constexpr int RW_STRIDE = 1024;
__device__ __forceinline__ void route_flush(LAS int* wb, int n, int lane, int* cnt, int* lists, TokInfo* info) {
    asm volatile("s_waitcnt lgkmcnt(0)" ::: "memory");
    if (lane < 2 * n) { const int i = lane >> 1, kk = lane & 1; const int e = wb[i * 8 + kk], t = wb[i * 8 + 4];
        const int s = atomicAdd(&cnt[e], 1); lists[e * T + s] = t; wb[i * 8 + 5 + kk] = s; }
    asm volatile("s_waitcnt lgkmcnt(0)" ::: "memory");
    if (lane < n) { TokInfo ti; ti.e0 = wb[lane * 8]; ti.e1 = wb[lane * 8 + 1]; ti.w0 = __int_as_float(wb[lane * 8 + 2]); ti.w1 = __int_as_float(wb[lane * 8 + 3]);
        ti.s0 = wb[lane * 8 + 5]; ti.s1 = wb[lane * 8 + 6]; ti.pad0 = 0; ti.pad1 = 0; info[wb[lane * 8 + 4]] = ti; }
    asm volatile("s_waitcnt lgkmcnt(0)" ::: "memory");
}
__device__ __forceinline__ void p5_stage_router(const Ctx& C, const Args& a) {
    float* hx = a.out; bf16_t* x1b = (bf16_t*)(a.ws + WS_X1B);
    const float* ln_w = (const float*)a.in[12]; const float* ln_b = (const float*)a.in[13];
    const float* wgr = (const float*)a.in[14]; const float* bgr = (const float*)a.in[15]; const float* wer = (const float*)a.in[16]; const float* ber = (const float*)a.in[17];
    int* cnt = (int*)(a.ws + WS_CTL) + CW_CNT; int* lists = (int*)(a.ws + WS_LISTS); TokInfo* info = (TokInfo*)(a.ws + WS_TOKINFO);
    LAS float* Wl = (LAS float*)C.lds;
    for (int i = C.tid; i < 1024; i += NTHREADS) { const f32x4 w = *(const f32x4*)(wgr + 4 * i);
#pragma unroll
        for (int j = 0; j < 4; ++j) Wl[j * RW_STRIDE + i] = w[j]; }
    for (int i = C.tid; i < 8192; i += NTHREADS) { const int k = i >> 3, j4 = (i & 7) * 4; const f32x4 w = *(const f32x4*)(wer + 4 * i);
#pragma unroll
        for (int j = 0; j < 4; ++j) Wl[(4 + j4 + j) * RW_STRIDE + k] = w[j]; }
    __syncthreads();
}
__device__ __forceinline__ void p5_ln1_router(const Ctx& C, const Args& a) {
    float* hx = a.out; bf16_t* x1b = (bf16_t*)(a.ws + WS_X1B);
    const float* ln_w = (const float*)a.in[12]; const float* ln_b = (const float*)a.in[13];
    const float* bgr = (const float*)a.in[15]; const float* ber = (const float*)a.in[17];
    int* cnt = (int*)(a.ws + WS_CTL) + CW_CNT; int* lists = (int*)(a.ws + WS_LISTS); TokInfo* info = (TokInfo*)(a.ws + WS_TOKINFO);
    LAS float* Wl = (LAS float*)C.lds;
    const int lane = C.lane;
    f32x4 lw[4], lb[4];
#pragma unroll
    for (int q = 0; q < 4; ++q) { lw[q] = *(const f32x4*)(ln_w + 256 * q + 4 * lane); lb[q] = *(const f32x4*)(ln_b + 256 * q + 4 * lane); }
    const int gw = C.vcu * NWAVES + C.wave, NGW = C.G * NWAVES;
    f32x4 vn[4];
    if (gw < T) {
#pragma unroll
        for (int q = 0; q < 4; ++q) vn[q] = *(const f32x4*)(hx + (size_t)gw * 1024 + 256 * q + 4 * lane);
    }
    LAS int* wb = (LAS int*)(C.lds + 147456 + C.wave * 1024); int nb = 0;
    for (int t = gw; t < T; t += NGW) {
        float* row = hx + (size_t)t * 1024;
        f32x4 v[4]; float s = 0.f;
#pragma unroll
        for (int q = 0; q < 4; ++q) { v[q] = vn[q]; s += (v[q][0] + v[q][1]) + (v[q][2] + v[q][3]); }
        if (t + NGW < T) {
#pragma unroll
            for (int q = 0; q < 4; ++q) vn[q] = *(const f32x4*)(row + (size_t)NGW * 1024 + 256 * q + 4 * lane);
        }
        const float mu = wave_sum(s) * (1.f / 1024.f); float sq = 0.f;
#pragma unroll
        for (int q = 0; q < 4; ++q) { v[q] = v[q] - mu; sq += (v[q][0] * v[q][0] + v[q][1] * v[q][1]) + (v[q][2] * v[q][2] + v[q][3] * v[q][3]); }
        const float rstd = rsqrtf(wave_sum(sq) * (1.f / 1024.f) + LN_EPS);
#pragma unroll
        for (int q = 0; q < 4; ++q) { v[q] = v[q] * rstd * lw[q] + lb[q]; *(f32x4*)(row + 256 * q + 4 * lane) = v[q];
            v2u o; o.x = pk2(v[q][0], v[q][1]); o.y = pk2(v[q][2], v[q][3]); *(v2u*)(x1b + (size_t)t * 1024 + 256 * q + 4 * lane) = o; }
        float lg[4];
#pragma unroll
        for (int j = 0; j < 4; ++j) { float p = 0.f;
#pragma unroll
            for (int q = 0; q < 4; ++q) { const f32x4 w = *(const LAS f32x4*)(Wl + j * RW_STRIDE + 256 * q + 4 * lane); p += (v[q][0] * w[0] + v[q][1] * w[1]) + (v[q][2] * w[2] + v[q][3] * w[3]); }
            lg[j] = wave_sum(p) + bgr[j]; }
        float m = lg[0]; int gs = 0;
#pragma unroll
        for (int j = 1; j < 4; ++j) if (lg[j] > m) { m = lg[j]; gs = j; }
        float den = 0.f;
#pragma unroll
        for (int j = 0; j < 4; ++j) den += __expf(lg[j] - m);
        const float pg = __builtin_amdgcn_rcpf(den);
        gs = __builtin_amdgcn_readfirstlane(gs);
        float el[8];
        const LAS float* We = Wl + (4 + gs * 8) * RW_STRIDE;
#pragma unroll
        for (int j = 0; j < 8; ++j) { float p = 0.f;
#pragma unroll
            for (int q = 0; q < 4; ++q) { const f32x4 w = *(const LAS f32x4*)(We + j * RW_STRIDE + 256 * q + 4 * lane); p += (v[q][0] * w[0] + v[q][1] * w[1]) + (v[q][2] * w[2] + v[q][3] * w[3]); }
            el[j] = wave_sum(p) + ber[gs * 8 + j]; }
        int i0 = 0; float v0 = el[0];
#pragma unroll
        for (int j = 1; j < 8; ++j) if (el[j] > v0) { v0 = el[j]; i0 = j; }
        int i1 = -1; float v1 = -3.0e38f;
#pragma unroll
        for (int j = 0; j < 8; ++j) if (j != i0 && el[j] > v1) { v1 = el[j]; i1 = j; }
        if (i1 < 0) i1 = (i0 == 0) ? 1 : 0;
        const float e1 = __expf(v1 - v0);
        if (lane == 0) { LAS int* e = wb + nb * 8; e[0] = gs * 8 + i0; e[1] = gs * 8 + i1; e[2] = __float_as_int(pg / (1.f + e1)); e[3] = __float_as_int(pg * e1 / (1.f + e1)); e[4] = t; }
        ++nb;
        if (nb == 32) { route_flush(wb, nb, lane, cnt, lists, info); nb = 0; }
    }
    if (nb) route_flush(wb, nb, lane, cnt, lists, info);
}
__device__ __forceinline__ void p7_final(const Ctx& C, const Args& a, const LAS int* base, float* dst) {
    float* x1 = a.out; const bf16_t* y = (const bf16_t*)(a.ws + WS_Y); const TokInfo* info = (const TokInfo*)(a.ws + WS_TOKINFO);
    const float* ln_w = (const float*)a.in[21]; const float* ln_b = (const float*)a.in[22];
    const int lane = C.lane;
    f32x4 lw[4], lb[4];
#pragma unroll
    for (int q = 0; q < 4; ++q) { lw[q] = *(const f32x4*)(ln_w + 256 * q + 4 * lane); lb[q] = *(const f32x4*)(ln_b + 256 * q + 4 * lane); }
    const int gw = C.vcu * NWAVES + C.wave, NGW = C.G * NWAVES;
    for (int t = gw; t < T; t += NGW) {
        const TokInfo ti = info[t];
        const bf16_t* y0 = y + (size_t)(base[ti.e0] + ti.s0) * 1024; const bf16_t* y1 = y + (size_t)(base[ti.e1] + ti.s1) * 1024;
        float* row = x1 + (size_t)t * 1024;
        f32x4 v[4]; float s = 0.f;
#pragma unroll
        for (int q = 0; q < 4; ++q) { const int c = 256 * q + 4 * lane; const v2u a0 = *(const v2u*)(y0 + c), a1 = *(const v2u*)(y1 + c);
            v[q] = *(const f32x4*)(row + c) * ALPHA + pg8::bf4_to_f32(a0.x, a0.y) * ti.w0 + pg8::bf4_to_f32(a1.x, a1.y) * ti.w1;
            s += (v[q][0] + v[q][1]) + (v[q][2] + v[q][3]); }
        const float mu = wave_sum(s) * (1.f / 1024.f); float sq = 0.f;
#pragma unroll
        for (int q = 0; q < 4; ++q) { v[q] = v[q] - mu; sq += (v[q][0] * v[q][0] + v[q][1] * v[q][1]) + (v[q][2] * v[q][2] + v[q][3] * v[q][3]); }
        const float rstd = rsqrtf(wave_sum(sq) * (1.f / 1024.f) + LN_EPS);
#pragma unroll
        for (int q = 0; q < 4; ++q) *(f32x4*)(dst + (size_t)t * 1024 + 256 * q + 4 * lane) = v[q] * rstd * lw[q] + lb[q];
    }
}

typedef short s16x4 __attribute__((ext_vector_type(4)));
#define MFMA32(a, b, c) __builtin_amdgcn_mfma_f32_32x32x16_bf16((a), (b), (c), 0, 0, 0)
__device__ __forceinline__ int crow(int i, int h) { return (i & 3) + 8 * (i >> 2) + 4 * h; }
__device__ __forceinline__ bf16x8 pack8(const f32x16& x, int s) {
    v4u p; p.x = pk2(x[8 * s], x[8 * s + 1]); p.y = pk2(x[8 * s + 2], x[8 * s + 3]); p.z = pk2(x[8 * s + 4], x[8 * s + 5]); p.w = pk2(x[8 * s + 6], x[8 * s + 7]);
    return __builtin_bit_cast(bf16x8, p);
}
__device__ __forceinline__ bf16x8 cvt8(const f32x4& a, const f32x4& b) { v4u p; p.x = pk2(a[0], a[1]); p.y = pk2(a[2], a[3]); p.z = pk2(b[0], b[1]); p.w = pk2(b[2], b[3]); return __builtin_bit_cast(bf16x8, p); }
__device__ __forceinline__ bf16x8 tr_frag(LAS unsigned char* img, int pitch, int k0, int k1, int mn0, int lane) {
    const int q4 = (lane & 15) >> 2, p4 = lane & 3, blk = (lane >> 4) & 1, cb = (mn0 + 16 * blk + 4 * p4) * 2;
    const s16x4 lo = __builtin_amdgcn_ds_read_tr16_b64_v4i16((LAS s16x4*)(img + (k0 + q4) * pitch + cb));
    const s16x4 hi = __builtin_amdgcn_ds_read_tr16_b64_v4i16((LAS s16x4*)(img + (k1 + q4) * pitch + cb));
    return __builtin_shufflevector(lo, hi, 0, 1, 2, 3, 4, 5, 6, 7);
}
__device__ __forceinline__ float gamma_log2(int h) { return pg8::log2_gamma(h); }

__device__ __forceinline__ void pooled_strip(const Ctx& C, const bf16_t* up, bf16_t* pooled, int strip) {
    const int cg = C.tid & 127, sub = C.tid >> 7, c = 4 * cg, w = 2 << (cg >> 5), t0 = strip * 64 + sub * 16, s0 = t0 & (SEQ - 1);
    f32x4 sum = {0.f, 0.f, 0.f, 0.f};
    for (int j = 1; j <= w; ++j) if (s0 - j >= 0) { const v2u x = *(const v2u*)(up + (size_t)(t0 - j) * 512 + c); sum += pg8::bf4_to_f32(x.x, x.y); }
#pragma unroll 4
    for (int i = 0; i < 16; ++i) { const int t = t0 + i, s = s0 + i; const v2u x = *(const v2u*)(up + (size_t)t * 512 + c); const f32x4 cur = pg8::bf4_to_f32(x.x, x.y);
        sum += cur; if (s - w >= 0) { const v2u y = *(const v2u*)(up + (size_t)(t - w) * 512 + c); sum -= pg8::bf4_to_f32(y.x, y.y); }
        const float inv = 1.f / (float)((s + 1 < w) ? s + 1 : w);
        const f32x4 o = sum * inv - cur; v2u ow; ow.x = pk2(o[0], o[1]); ow.y = pk2(o[2], o[3]); *(v2u*)(pooled + (size_t)t * 512 + c) = ow; }
}
template <bool STORE = true>
__device__ __forceinline__ void xattn_unit(const Ctx& C, bf16_t* xq, const bf16_t* mk, const bf16_t* mv, int unit) {
    const int qt = unit & 15, h = (unit >> 4) & 3, b = unit >> 6;
    LAS unsigned char* Kl = C.lds; LAS unsigned char* Vl = C.lds + 69632;
#pragma unroll
    for (int it = 0; it < 8; ++it) { const int idx = C.tid + it * 512, row = idx >> 4, ch = idx & 15;
        const size_t src = ((size_t)(b * MEML + row) * 512 + h * 128) * 2 + ch * 16;
        const v4u kv = *(const v4u*)((const char*)mk + src), vv = *(const v4u*)((const char*)mv + src);
        *(LAS v4u*)(Kl + row * 272 + ch * 16) = kv; *(LAS v4u*)(Vl + row * 320 + ch * 16) = vv; }
    __syncthreads();
    const int lane = C.lane, r = lane & 31, h2 = lane >> 5;
    bf16_t* qrow = xq + ((size_t)b * SEQ + qt * 256 + C.wave * 32 + r) * 512 + h * 128;
    bf16x8 qf[8];
#pragma unroll
    for (int ks = 0; ks < 8; ++ks) qf[ks] = *(const bf16x8*)(qrow + 16 * ks + 8 * h2);
    f32x16 ot[4];
#pragma unroll
    for (int db = 0; db < 4; ++db)
#pragma unroll
        for (int i = 0; i < 16; ++i) ot[db][i] = 0.f;
    float m_run = -3.0e38f, sum = 0.f;
#pragma unroll 1
    for (int qtr = 0; qtr < 4; ++qtr) {
        f32x16 st[2];
#pragma unroll
        for (int kq = 0; kq < 2; ++kq) { LAS unsigned char* kp = Kl + (64 * qtr + 32 * kq + r) * 272 + 16 * h2;
#pragma unroll
            for (int i = 0; i < 16; ++i) st[kq][i] = 0.f;
#pragma unroll
            for (int ks = 0; ks < 8; ++ks) { const bf16x8 kf = *(const LAS bf16x8*)(kp + 32 * ks); st[kq] = MFMA32(kf, qf[ks], st[kq]); }
        }
        float mh = -3.0e38f;
#pragma unroll
        for (int kq = 0; kq < 2; ++kq)
#pragma unroll
            for (int i = 0; i < 16; ++i) mh = fmaxf(mh, st[kq][i]);
        mh = fmaxf(mh, __shfl_xor(mh, 32));
        const float m_new = fmaxf(m_run, mh), alpha = __builtin_amdgcn_exp2f((m_run - m_new) * 1.4426950408889634f);
        sum *= alpha;
#pragma unroll
        for (int db = 0; db < 4; ++db)
#pragma unroll
            for (int i = 0; i < 16; ++i) ot[db][i] *= alpha;
        m_run = m_new;
#pragma unroll
        for (int kq = 0; kq < 2; ++kq)
#pragma unroll
            for (int i = 0; i < 16; ++i) { const float p = __builtin_amdgcn_exp2f((st[kq][i] - m_new) * 1.4426950408889634f); st[kq][i] = p; sum += p; }
#pragma unroll
        for (int kq = 0; kq < 2; ++kq)
#pragma unroll
            for (int s = 0; s < 2; ++s) { const bf16x8 pb = pack8(st[kq], s); const int k0 = 64 * qtr + 32 * kq + 16 * s + 4 * h2;
#pragma unroll
                for (int db = 0; db < 4; ++db) { const bf16x8 vf = tr_frag(Vl, 320, k0, k0 + 8, 32 * db, lane); ot[db] = MFMA32(vf, pb, ot[db]); } }
    }
    sum += __shfl_xor(sum, 32);
    const float inv = 1.f / sum;
#pragma unroll
    for (int db = 0; db < 4; ++db)
#pragma unroll
        for (int gq = 0; gq < 4; ++gq) { v2u w; w.x = pk2(ot[db][4 * gq] * inv, ot[db][4 * gq + 1] * inv); w.y = pk2(ot[db][4 * gq + 2] * inv, ot[db][4 * gq + 3] * inv);
            if (STORE) *(v2u*)(qrow + 32 * db + 8 * gq + 4 * h2) = w; else asm volatile("" :: "v"(w.x), "v"(w.y)); }
    __syncthreads();
}
template <bool WITH_K>
__device__ __forceinline__ void stage_chunk(const Ctx& C, const bf16_t* k, const bf16_t* v, size_t t0, int h) {
#pragma unroll
    for (int it = 0; it < 8; ++it) { const int idx = C.tid + it * 512, row = idx >> 5, ch = idx & 31;
        const v4u x = *(const v4u*)(v + (t0 + row) * 1024 + h * 256 + ch * 8); *(LAS v4u*)(C.lds + row * 576 + ch * 16) = x; }
    if (WITH_K) {
#pragma unroll
        for (int it = 0; it < 4; ++it) { const int idx = C.tid + it * 512, row = idx >> 4, ch = idx & 15;
            const v4u x = *(const v4u*)(k + (t0 + row) * 512 + h * 128 + ch * 8); *(LAS v4u*)(C.lds + 73728 + row * 320 + ch * 16) = x; }
    }
}
__device__ __forceinline__ void ret_state_unit(const Ctx& C, const bf16_t* k, const bf16_t* v, bf16_t* kvb, int u) {
    const int h = u & 3; const size_t t0 = (size_t)(u >> 2) * CH;
    stage_chunk<true>(C, k, v, t0, h);
    __syncthreads();
    LAS unsigned char* Vl = C.lds; LAS unsigned char* Kl = C.lds + 73728;
    const int lane = C.lane, r = lane & 31, h2 = lane >> 5, eb = C.wave;
    f32x16 acc[4];
#pragma unroll
    for (int db = 0; db < 4; ++db)
#pragma unroll
        for (int i = 0; i < 16; ++i) acc[db][i] = 0.f;
#pragma unroll
    for (int ks = 0; ks < 8; ++ks) { const int k0 = 16 * ks + 8 * h2;
        const bf16x8 bfv = tr_frag(Vl, 576, k0, k0 + 4, 32 * eb, lane);
#pragma unroll
        for (int db = 0; db < 4; ++db) { const bf16x8 afk = tr_frag(Kl, 320, k0, k0 + 4, 32 * db, lane); acc[db] = MFMA32(afk, bfv, acc[db]); } }
    const float sc = __builtin_amdgcn_exp2f((float)(CH - 1) * gamma_log2(h));
    bf16_t* out = kvb + ((size_t)u * 256 + 32 * eb + r) * 128;
#pragma unroll
    for (int db = 0; db < 4; ++db)
#pragma unroll
        for (int gq = 0; gq < 4; ++gq) { v2u w; w.x = pk2(acc[db][4 * gq] * sc, acc[db][4 * gq + 1] * sc); w.y = pk2(acc[db][4 * gq + 2] * sc, acc[db][4 * gq + 3] * sc);
            *(v2u*)(out + 32 * db + 8 * gq + 4 * h2) = w; }
    __syncthreads();
}
__device__ __forceinline__ void scan_all(const Ctx& C, const bf16_t* kvb, bf16_t* prevb) {
    const size_t nthr = (size_t)C.G * NTHREADS;
    for (size_t idx = (size_t)C.vcu * NTHREADS + C.tid; idx < (size_t)BATCH * 4 * 8192; idx += nthr) {
        const int ed4 = (int)(idx & 8191), h = (int)((idx >> 13) & 3), b = (int)(idx >> 15);
        const float cd = __builtin_amdgcn_exp2f((float)CH * gamma_log2(h));
        v2u inc[NCH];
#pragma unroll
        for (int n = 0; n < NCH; ++n) inc[n] = *(const v2u*)(kvb + ((size_t)((b * NCH + n) * 4 + h)) * 32768 + ed4 * 4);
        f32x4 st = {0.f, 0.f, 0.f, 0.f};
#pragma unroll
        for (int n = 0; n < NCH; ++n) { v2u o; o.x = pk2(st[0], st[1]); o.y = pk2(st[2], st[3]);
            *(v2u*)(prevb + ((size_t)((b * NCH + n) * 4 + h)) * 32768 + ed4 * 4) = o; st = st * cd + pg8::bf4_to_f32(inc[n].x, inc[n].y); }
    }
}
template <bool STORE = true>
__device__ __forceinline__ void ret_out_unit(const Ctx& C, const bf16_t* q, const bf16_t* k, const bf16_t* v, const bf16_t* prevb, bf16_t* g, const float* gn_w, int u) {
    const int h = u & 3; const size_t t0 = (size_t)(u >> 2) * CH;
    stage_chunk<false>(C, k, v, t0, h);
    LAS unsigned char* Vl = C.lds; LAS unsigned char* Pl = C.lds + 73728; LAS float* red = (LAS float*)(C.lds + 73728 + 69632);
#pragma unroll
    for (int it = 0; it < 8; ++it) { const int idx = C.tid + it * 512, row = idx >> 4, ch = idx & 15;
        const v4u x = *(const v4u*)(prevb + ((size_t)u * 256 + row) * 128 + ch * 8); *(LAS v4u*)(Pl + row * 272 + ch * 16) = x; }
    __syncthreads();
    const int lane = C.lane, r = lane & 31, h2 = lane >> 5, cb = C.wave & 3, eh = C.wave >> 2;
    const size_t tokq = t0 + 32 * cb + r;
    const bf16_t* qrow = q + tokq * 512 + h * 128;
    bf16x8 qf[8];
#pragma unroll
    for (int ks = 0; ks < 8; ++ks) qf[ks] = *(const bf16x8*)(qrow + 16 * ks + 8 * h2);
    f32x16 yt[4];
#pragma unroll
    for (int el = 0; el < 4; ++el)
#pragma unroll
        for (int i = 0; i < 16; ++i) yt[el][i] = 0.f;
#pragma unroll
    for (int ks = 0; ks < 8; ++ks)
#pragma unroll
        for (int el = 0; el < 4; ++el) { const bf16x8 af = *(const LAS bf16x8*)(Pl + (32 * (4 * eh + el) + r) * 272 + (16 * ks + 8 * h2) * 2); yt[el] = MFMA32(af, qf[ks], yt[el]); }
    const float gam = __builtin_amdgcn_exp2f(gamma_log2(h));
#pragma unroll
    for (int el = 0; el < 4; ++el)
#pragma unroll
        for (int i = 0; i < 16; ++i) yt[el][i] *= gam;
    for (int sb = 0; sb <= cb; ++sb) {
        f32x16 sblk;
#pragma unroll
        for (int i = 0; i < 16; ++i) sblk[i] = 0.f;
        const bf16_t* krow = k + (t0 + 32 * sb + r) * 512 + h * 128;
#pragma unroll
        for (int ks = 0; ks < 8; ++ks) { const bf16x8 kf = *(const bf16x8*)(krow + 16 * ks + 8 * h2); sblk = MFMA32(kf, qf[ks], sblk); }
        if (sb == cb) {
#pragma unroll
            for (int i = 0; i < 16; ++i) sblk[i] = (crow(i, h2) > r) ? 0.f : sblk[i];
        }
#pragma unroll
        for (int s = 0; s < 2; ++s) { const bf16x8 pb = pack8(sblk, s); const int k0 = 32 * sb + 16 * s + 4 * h2;
#pragma unroll
            for (int el = 0; el < 4; ++el) { const bf16x8 vf = tr_frag(Vl, 576, k0, k0 + 8, 32 * (4 * eh + el), lane); yt[el] = MFMA32(vf, pb, yt[el]); } }
    }
    float s1 = 0.f;
#pragma unroll
    for (int el = 0; el < 4; ++el)
#pragma unroll
        for (int i = 0; i < 16; ++i) s1 += yt[el][i];
    s1 += __shfl_xor(s1, 32);
    if (h2 == 0) red[C.wave * 32 + r] = s1;
    __syncthreads();
    const float mean = (s1 + red[(C.wave ^ 4) * 32 + r]) * (1.f / 256.f);
    float s2 = 0.f;
#pragma unroll
    for (int el = 0; el < 4; ++el)
#pragma unroll
        for (int i = 0; i < 16; ++i) { const float d = yt[el][i] - mean; s2 += d * d; }
    s2 += __shfl_xor(s2, 32);
    if (h2 == 0) red[256 + C.wave * 32 + r] = s2;
    __syncthreads();
    const float rstd = rsqrtf((s2 + red[256 + (C.wave ^ 4) * 32 + r]) * (1.f / 256.f) + LN_EPS);
    bf16_t* grow = g + tokq * 1024 + h * 256;
#pragma unroll
    for (int el = 0; el < 4; ++el)
#pragma unroll
        for (int gq = 0; gq < 4; ++gq) { const int e0 = 32 * (4 * eh + el) + 8 * gq + 4 * h2;
            const f32x4 w = *(const f32x4*)(gn_w + h * 256 + e0); const v2u gs = *(const v2u*)(grow + e0); const f32x4 gf = pg8::bf4_to_f32(gs.x, gs.y);
            f32x4 o;
#pragma unroll
            for (int j = 0; j < 4; ++j) o[j] = (yt[el][4 * gq + j] - mean) * rstd * w[j] * gf[j];
            v2u ow; ow.x = pk2(o[0], o[1]); ow.y = pk2(o[2], o[3]); if (STORE) *(v2u*)(grow + e0) = ow; else asm volatile("" :: "v"(ow.x), "v"(ow.y)); }
    __syncthreads();
}

__global__ void __launch_bounds__(NTHREADS, 2) mega(Args a) {
    extern __shared__ __attribute__((aligned(16))) unsigned char lds_raw[];
    Ctx C; C.lds = (LAS unsigned char*)lds_raw; C.tid = threadIdx.x; C.lane = C.tid & 63; C.wave = __builtin_amdgcn_readfirstlane(C.tid >> 6);
    C.G = gridDim.x; { const int bx = blockIdx.x; C.vcu = (C.G % 8 == 0) ? (bx % 8) * (C.G / 8) + bx / 8 : bx; }
    volatile LAS unsigned* MISC = (volatile LAS unsigned*)(C.lds + MISC_OFF);
    if (C.tid < 64) MISC[C.tid] = 0u;
    __syncthreads();
    XcdBarrier bar = xcd_barrier_post((unsigned*)(a.ws + WS_CTL) + CW_BAR + a.li * XCD_BAR_WORDS, MISC + 8);
#if defined(TS_A)
#define STAMP(i) do { if (C.vcu == 0 && C.tid == 0) MISC[16 + (i)] = (unsigned)__builtin_amdgcn_s_memrealtime(); } while (0)
#else
#define STAMP(i) do {} while (0)
#endif
    STAMP(0);
    const int lo = a.ph_lo, hi = a.ph_hi;
#define IN(k) (lo <= (k) && (k) < hi)
#define BOTH(k) (IN(k) && IN((k) + 1))
    unsigned char* dout = (unsigned char*)a.out; unsigned char* ws = a.ws;
    if (IN(0)) { REP(0) p0_prologue(C, a); if (BOTH(0)) xcd_barrier(bar); STAMP(1); }
    if (IN(1)) {
        REP(1) { pg8::Gemm g{(const bf16_t*)(dout + DO_XB), (const bf16_t*)(dout + DO_WINT), T, NIN, 1024}; pg8::StaticOrder S; S.init(T, NIN, C.G, (int)blockIdx.x);
          pg8::EpiProj E{(bf16_t*)(ws + WS_UPOOL), (bf16_t*)(ws + WS_Q), (bf16_t*)(ws + WS_K), (bf16_t*)(ws + WS_V), (bf16_t*)(ws + WS_G), (bf16_t*)(ws + WS_XQ), (bf16_t*)(ws + WS_GATES), (const float*)(dout + DO_CS)};
          pg8::gemm_phase<pg8::EpiProj, pg8::StaticOrder, true, true>(C.lds, g, S, E); }
        if (BOTH(1)) xcd_barrier(bar); STAMP(2);
    }
    if (IN(2)) {
        const int nh = (C.G >= 64) ? 16 : 0;
        if (C.vcu < nh || nh == 0) {
            pg8::Gemm g{(const bf16_t*)(ws + WS_MEMB), (const bf16_t*)(ws + WS_WMEMT), BATCH * MEML, 1024, 1024}; pg8::StaticOrder S; S.init(BATCH * MEML, 1024, nh ? nh : C.G, C.vcu);
            pg8::EpiMemKV E{(bf16_t*)(ws + WS_MEMK), (bf16_t*)(ws + WS_MEMV)};
            pg8::gemm_phase<pg8::EpiMemKV, pg8::StaticOrder, true, true>(C.lds, g, S, E);
        }
        if (C.vcu >= nh) {
            const int w0 = C.vcu - nh, nw = C.G - nh;
            for (int s = w0; s < T / 64; s += nw) pooled_strip(C, (const bf16_t*)(ws + WS_UPOOL), (bf16_t*)(ws + WS_POOLED), s);
            for (int u = w0; u < BATCH * NCH * 4; u += nw) ret_state_unit(C, (const bf16_t*)(ws + WS_K), (const bf16_t*)(ws + WS_V), (bf16_t*)dout, u);
        }
        if (BOTH(2)) xcd_barrier(bar); STAMP(3);
    }
    if (IN(3)) {
        for (int u = C.vcu; u < BATCH * 4 * (SEQ / 256); u += C.G) xattn_unit(C, (bf16_t*)(ws + WS_XQ), (const bf16_t*)(ws + WS_MEMK), (const bf16_t*)(ws + WS_MEMV), u);
        STAMP(14); scan_all(C, (const bf16_t*)dout, (bf16_t*)(dout + 32 * MiB)); STAMP(15);
        REP(3) { pg8::Gemm g{(const bf16_t*)(ws + WS_POOLED), (const bf16_t*)(ws + WS_WPOOLBD), T, 512, 512}; pg8::StaticOrder S; S.init(T, 512, C.G, (int)blockIdx.x);
        pg8::EpiPoolMap E{(bf16_t*)(ws + WS_UPOOL), (const float*)a.in[5]};
        pg8::gemm_phase<pg8::EpiPoolMap, pg8::StaticOrder, true, true>(C.lds, g, S, E); }
        if (BOTH(3)) xcd_barrier(bar); STAMP(4);
    }
    if (IN(4)) {
        for (int u = C.vcu; u < BATCH * NCH * 4; u += C.G) ret_out_unit(C, (const bf16_t*)(ws + WS_Q), (const bf16_t*)(ws + WS_K), (const bf16_t*)(ws + WS_V), (const bf16_t*)(dout + 32 * MiB), (bf16_t*)(ws + WS_G), (const float*)a.in[6], u);
        if (BOTH(4)) xcd_barrier(bar); STAMP(5);
    }
    if (IN(5)) {
        const bf16_t* gates = (const bf16_t*)(ws + WS_GATES); bf16_t* merged = (bf16_t*)(ws + WS_MERGED);
        pg8::StaticOrder S; S.init(T, 1024, C.G, (int)blockIdx.x);
        REP(5) {
        { pg8::Gemm g{(const bf16_t*)(ws + WS_UPOOL), (const bf16_t*)(ws + WS_WPT), T, 1024, 512}; pg8::EpiGate<true> E{merged, gates, 0};
          pg8::gemm_phase<pg8::EpiGate<true>, pg8::StaticOrder, true, true>(C.lds, g, S, E); }
        __builtin_amdgcn_fence(__ATOMIC_ACQUIRE, "agent");
        { pg8::Gemm g{(const bf16_t*)(ws + WS_G), (const bf16_t*)(ws + WS_WRT), T, 1024, 1024}; pg8::EpiGate<false> E{merged, gates, 1024};
          pg8::gemm_phase<pg8::EpiGate<false>, pg8::StaticOrder, true, true>(C.lds, g, S, E); }
        __builtin_amdgcn_fence(__ATOMIC_ACQUIRE, "agent");
        { pg8::Gemm g{(const bf16_t*)(ws + WS_XQ), (const bf16_t*)(ws + WS_WXT), T, 1024, 512}; pg8::EpiGate<false> E{merged, gates, 2048};
          pg8::gemm_phase<pg8::EpiGate<false>, pg8::StaticOrder, true, true>(C.lds, g, S, E); }
        __builtin_amdgcn_fence(__ATOMIC_ACQUIRE, "agent"); }
        if (BOTH(5)) xcd_barrier(bar); STAMP(6);
    }
    if (IN(6)) {
        pg8::Gemm g{(const bf16_t*)(ws + WS_MERGED), (const bf16_t*)(ws + WS_WOUTT), T, 1024, 1024}; pg8::StaticOrder S; S.init(T, 1024, C.G, (int)blockIdx.x);
        pg8::EpiResid E{a.out, (const float*)a.in[0]};
        REP(6) pg8::gemm_phase<pg8::EpiResid, pg8::StaticOrder, true, true>(C.lds, g, S, E);
        if (BOTH(6)) xcd_barrier(bar); STAMP(7);
    }
    if (IN(7)) {
        moe_convert_weights(C, a);
        __syncthreads(); STAMP(12);
        p5_stage_router(C, a); STAMP(13);
        p5_ln1_router(C, a);
        if (BOTH(7)) xcd_barrier(bar); STAMP(8);
    }
    LAS int* mbase = (LAS int*)(C.lds + RING_BYTES);
    const int* cntp = (const int*)(ws + WS_CTL) + CW_CNT;
    if (IN(8)) {
        compute_base(C, cntp, mbase);
        pg8::MoeSched<true> S{mbase, cntp, (const int*)(ws + WS_LISTS), (const char*)(ws + WS_X1B), (const char*)(ws + WS_MOEW1), (size_t)512 * 1024 * 2, 1024, 2, C.G, (int)blockIdx.x};
        pg8::EpiMoeAct E{(bf16_t*)(ws + WS_ACT)};
        REP(8) pg8::gemm_phase_g<pg8::EpiMoeAct, pg8::MoeSched<true>>(C.lds, 1024, S, E);
        if (BOTH(8)) xcd_barrier(bar); STAMP(9);
    }
    if (IN(9)) {
        compute_base(C, cntp, mbase);
        pg8::Gemm g{(const bf16_t*)(ws + WS_ACT), (const bf16_t*)(ws + WS_MOEW2), 40960, 32 * 1024, 256}; pg8::MoeOrder S{mbase, 4, C.G, (int)blockIdx.x};
        pg8::EpiMoeY E{(bf16_t*)(ws + WS_Y)};
        REP(9) pg8::gemm_phase<pg8::EpiMoeY, pg8::MoeOrder, true, true>(C.lds, g, S, E);
        if (BOTH(9)) xcd_barrier(bar); STAMP(10);
    }
    if (IN(10)) {
        compute_base(C, cntp, mbase);
        p7_final(C, a, mbase, a.out);
        STAMP(11);
#if defined(TS_A)
        __syncthreads();
        if (C.vcu == 0 && C.tid == 0) { const unsigned d = MISC[16 + TS_B] - MISC[16 + TS_A]; a.out[0] += (float)(TS_SCALE) * (float)d; }
#endif
    }
#undef IN
#undef BOTH
}

static int g_grid = 0;
static void launch_mega(hipStream_t stream, Args a, int lo, int hi, int li) {
    a.ph_lo = lo; a.ph_hi = hi; a.li = li; a.pad = 0;
    hipLaunchKernelGGL(mega, dim3(g_grid), dim3(NTHREADS), LDS_BYTES, stream, a);
    const hipError_t e = hipPeekAtLastError();
    if (e != hipSuccess) fprintf(stderr, "kernel_launch: launch failed: %s (grid %d)\n", hipGetErrorString(e), g_grid);
}

extern "C" void kernel_launch(void* const* d_in, const int* in_sizes, int n_in, void* d_out, int out_size, void* d_ws, size_t ws_size, hipStream_t stream) {
    if (g_grid == 0) {
        int dev = 0, cus = 0, per_cu = 0;
        (void)hipGetDevice(&dev); (void)hipDeviceGetAttribute(&cus, hipDeviceAttributeMultiprocessorCount, dev);
        (void)hipFuncSetAttribute((const void*)mega, hipFuncAttributeMaxDynamicSharedMemorySize, LDS_BYTES);
        (void)hipOccupancyMaxActiveBlocksPerMultiprocessor(&per_cu, (const void*)mega, NTHREADS, LDS_BYTES);
        if (per_cu < 1) { fprintf(stderr, "kernel_launch: occupancy query reports %d blocks per CU\n", per_cu); per_cu = 1; }
        g_grid = cus;
    }
    Args a{}; for (int i = 0; i < 23; ++i) a.in[i] = d_in[i]; a.out = (float*)d_out; a.ws = (unsigned char*)d_ws;
    (void)hipMemsetAsync((unsigned char*)d_ws + WS_CTL, 0, 1 * MiB, stream);
    launch_mega(stream, a, 0, 11, 0);
}
```

```cpp
#include <hip/hip_runtime.h>
#include <stdint.h>
#include <math.h>
#include <cstdio>

typedef unsigned short bf16_t;
__device__ __forceinline__ float bf2f(bf16_t h) { return __uint_as_float(((unsigned)h) << 16); }
__device__ __forceinline__ bf16_t f2bf(float f) { unsigned u = __float_as_uint(f); return (bf16_t)((u + 0x7fffu + ((u >> 16) & 1u)) >> 16); }

constexpr int D = 1024, BATCH = 4, SEQ = 4096, T = BATCH * SEQ, MEML = 256;
constexpr int NIN = 7168;
constexpr int CH = 128, NCH = SEQ / CH;
constexpr int NEXP = 32, DEXP = 256;
constexpr float LN_EPS = 1e-5f;
constexpr float ALPHA = 1.189207115002721f;
constexpr size_t MiB = 1u << 20;
constexpr size_t WS_CTL = 0, WS_TOKINFO = 1 * MiB, WS_LISTS = 2 * MiB;
constexpr size_t WS_WPT = 4 * MiB, WS_WRT = 5 * MiB, WS_WXT = 7 * MiB, WS_WOUTT = 8 * MiB, WS_WPOOLBD = 10 * MiB;
constexpr size_t WS_MEMK = 11 * MiB, WS_MEMV = 12 * MiB, WS_POOLED = 13 * MiB;
constexpr size_t WS_UPOOL = 32 * MiB, WS_Q = 48 * MiB, WS_K = 64 * MiB, WS_V = 80 * MiB, WS_G = 112 * MiB, WS_XQ = 144 * MiB, WS_GATES = 160 * MiB;
constexpr size_t WS_MERGED = 48 * MiB, WS_X1B = 80 * MiB, WS_ACT = 32 * MiB, WS_TMP = 52 * MiB, WS_Y = 176 * MiB;
constexpr size_t WS_MOEW1 = 112 * MiB, WS_MOEW2 = 144 * MiB;
constexpr size_t DO_XB = 0, DO_WINT = 32 * MiB, DO_CS = 50 * MiB;
constexpr size_t WS_MEMB = 1 * MiB, WS_WMEMT = 29 * MiB;
constexpr int CW_CNT = 1024;
constexpr int CW_BASE = 1088;
constexpr int CW_BAR = 4096;
#ifndef PHASE_REP
#define PHASE_REP -1
#endif
#define REP(k) for (int rep_ = 0; rep_ < ((PHASE_REP) == (k) ? 2 : 1); ++rep_)

namespace pg8 {
#define PG8_LAS __attribute__((address_space(3)))
typedef unsigned short bf16_t;
typedef short bf16x8 __attribute__((ext_vector_type(8)));
typedef float f32x4 __attribute__((ext_vector_type(4)));
typedef unsigned u32x4 __attribute__((ext_vector_type(4)));
constexpr int BM = 256, BK = 64, HALF = 128, HTB = HALF * BK * 2  , STAGE_BYTES = 8 * HTB, NXCD = 8, WGM = 8;

__host__ __device__ __forceinline__ int lds_byte(int r, int c) { const int st = (r >> 4) * 2 + (c >> 5), rr = r & 15, cc = c & 31, ob = rr * 64 + cc * 2; return st * 1024 + (ob ^ (((ob >> 9) & 1) << 5)); }
__host__ __device__ __forceinline__ void stage_rc(int b, int& R, int& C) { const int st = b / 1024, sb = b % 1024, swz = sb ^ (((sb >> 9) & 1) << 5); R = (st >> 1) * 16 + swz / 64; C = (st & 1) * 32 + (swz % 64) / 2; }
__host__ __device__ __forceinline__ int perm32(int rho) { const int n = rho >> 4, i = rho & 15; return 8 * (i >> 2) + 4 * n + (i & 3); }

struct Unit { int pm, pn; };
struct Gemm { const bf16_t* A; const bf16_t* Bt; int M, N, K; };

struct StaticOrder {
    int nM, nN, nwg, G, c;
    __host__ __device__ void init(int M, int N, int G_, int c_) { nM = M / BM; nN = N / BM; nwg = nM * nN; G = G_; c = c_; }
    __host__ __device__ bool next(int i, Unit& u) const {
        const long L = (long)i * G + c; if (L >= nwg) return false;
        int wgid = (int)L; { const int q = nwg / NXCD, r = nwg % NXCD, xcd = wgid % NXCD, off = wgid / NXCD; wgid = (xcd < r ? xcd * (q + 1) : r * (q + 1) + (xcd - r) * q) + off; }
        const int nig = WGM * nN, gid = wgid / nig, fm = gid * WGM, gsz = (nM - fm) < WGM ? (nM - fm) : WGM;
        u.pm = fm + ((wgid % nig) % gsz); u.pn = (wgid % nig) / gsz; return true;
    }
    __device__ __forceinline__ void a_ready(const Unit&) const {}
    __device__ __forceinline__ void done(const Unit&) const {}
};


template <class Epi, class Sched, bool ALIGN_EPI = false, bool SP2 = false>
__device__ __forceinline__ void gemm_phase(PG8_LAS unsigned char* lds, const Gemm g, const Sched& S, const Epi& E) {
    const int tid = threadIdx.x, wid = __builtin_amdgcn_readfirstlane(tid >> 6), lane = tid & 63, wr = wid >> 2, wc = wid & 3, fr = lane & 15, fq = lane >> 4;
    const int K = g.K, nt = K / BK;
    unsigned voffA[2], voffB[2];
#pragma unroll
    for (int i = 0; i < 2; ++i) { int R, C; stage_rc(tid * 16 + i * 8192, R, C); const int Rb = Epi::PERM ? ((R & ~31) + perm32(R & 31)) : R;
        voffA[i] = (unsigned)(R * K + C) * 2u; voffB[i] = (unsigned)(Rb * K + C) * 2u; }
    const size_t kstep = (size_t)(BK * 2);
    const size_t hstep = (size_t)HALF * K * 2;
    const size_t tstep = 2 * hstep;
    const unsigned ldsw = (unsigned)wid * 1024u;
    const int aoff = lds_byte(wr * 64 + fr, fq * 8), boff = lds_byte(wc * 32 + fr, fq * 8);
#define PG8_SA(b, h) (((b) * 2 + (h)) * HTB)
#define PG8_SB(b, h) ((4 + (b) * 2 + (h)) * HTB)
#define PG8_STAGE(bufoff, gbase, voff) do { _Pragma("unroll") for (int _i = 0; _i < 2; ++_i) \
        __builtin_amdgcn_global_load_lds((const unsigned*)((const char*)(gbase) + (voff)[_i]), (PG8_LAS unsigned*)(lds + (bufoff) + ldsw + _i * 8192), 16, 0, 0); } while (0)
#define PG8_LDA(dst, b, h) do { _Pragma("unroll") for (int m = 0; m < 4; ++m) _Pragma("unroll") for (int k = 0; k < 2; ++k) dst[m][k] = *(const PG8_LAS bf16x8*)(lds + PG8_SA(b, h) + aoff + m * 2048 + k * 1024); } while (0)
#define PG8_LDB(dst, b, h) do { _Pragma("unroll") for (int n = 0; n < 2; ++n) _Pragma("unroll") for (int k = 0; k < 2; ++k) dst[n][k] = *(const PG8_LAS bf16x8*)(lds + PG8_SB(b, h) + boff + n * 2048 + k * 1024); } while (0)
#define PG8_MMA(ai, bj, At, Bt) do { __builtin_amdgcn_s_setprio(1); _Pragma("unroll") for (int m = 0; m < 4; ++m) _Pragma("unroll") for (int n = 0; n < 2; ++n) _Pragma("unroll") for (int k = 0; k < 2; ++k) \
        acc[ai][bj][m][n] = __builtin_amdgcn_mfma_f32_16x16x32_bf16(Bt[n][k], At[m][k], acc[ai][bj][m][n], 0, 0, 0); __builtin_amdgcn_s_setprio(0); } while (0)
#define PG8_WAIT_V(n) asm volatile("s_waitcnt vmcnt(" #n ")" ::: "memory")
#define PG8_WAIT_L(n) asm volatile("s_waitcnt lgkmcnt(" #n ")" ::: "memory")
#define PG8_BAR __builtin_amdgcn_s_barrier()
#define PG8_SCHED __builtin_amdgcn_sched_barrier(0)
    Unit cur, nxt; int ui = 0;
    if (!S.next(0, cur)) return;
    f32x4 acc[2][2][4][2];
#pragma unroll
    for (int a = 0; a < 2; ++a)
#pragma unroll
        for (int b = 0; b < 2; ++b)
#pragma unroll
            for (int m = 0; m < 4; ++m)
#pragma unroll
                for (int n = 0; n < 2; ++n) acc[a][b][m][n] = (f32x4){0.f, 0.f, 0.f, 0.f};
    bf16x8 At[4][2], B0[2][2], B1[2][2];
    const char* cA = (const char*)g.A + (size_t)cur.pm * tstep; const char* cB = (const char*)g.Bt + (size_t)cur.pn * tstep;
    S.a_ready(cur);
    if constexpr (SP2) {
        PG8_STAGE(PG8_SB(0, 0), cB, voffB); PG8_STAGE(PG8_SB(0, 1), cB + hstep, voffB); PG8_STAGE(PG8_SA(0, 0), cA, voffA); PG8_STAGE(PG8_SA(0, 1), cA + hstep, voffA);
        if (wr == 1) PG8_BAR;
        PG8_WAIT_V(2); PG8_BAR;
        PG8_STAGE(PG8_SB(1, 0), cB + kstep, voffB); PG8_STAGE(PG8_SA(1, 0), cA + kstep, voffA); PG8_STAGE(PG8_SB(1, 1), cB + hstep + kstep, voffB);
        PG8_WAIT_V(6); PG8_BAR;
    } else {
        PG8_STAGE(PG8_SB(0, 0), cB, voffB); PG8_STAGE(PG8_SA(0, 0), cA, voffA); PG8_STAGE(PG8_SB(0, 1), cB + hstep, voffB); PG8_STAGE(PG8_SA(0, 1), cA + hstep, voffA);
        if (wr == 1) PG8_BAR;
        PG8_WAIT_V(4); PG8_BAR;
        PG8_STAGE(PG8_SB(1, 0), cB + kstep, voffB); PG8_STAGE(PG8_SA(1, 0), cA + kstep, voffA); PG8_STAGE(PG8_SB(1, 1), cB + hstep + kstep, voffB);
        PG8_WAIT_V(6); PG8_BAR;
    }
    for (;;) {
        const bool has_next = S.next(ui + 1, nxt);
        const char* nA = has_next ? (const char*)g.A + (size_t)nxt.pm * tstep : cA; const char* nB = has_next ? (const char*)g.Bt + (size_t)nxt.pn * tstep : cB;
#pragma unroll 1
        for (int t = 0; t < nt; t += 2) {
            const bool last = (t == nt - 2);
            const char* a1 = cA + (size_t)(t + 1) * kstep;
            const char* a2 = last ? nA : cA + (size_t)(t + 2) * kstep; const char* b2 = last ? nB : cB + (size_t)(t + 2) * kstep;
            const char* a3 = a2 + kstep; const char* b3 = b2 + kstep;
            if (last && has_next) S.a_ready(nxt);
            if constexpr (SP2) {
            PG8_LDB(B0, 0, 0); PG8_LDB(B1, 0, 1); PG8_SCHED; PG8_LDA(At, 0, 0); PG8_STAGE(PG8_SA(1, 1), a1 + hstep, voffA);
            PG8_WAIT_V(8); PG8_WAIT_L(0); PG8_BAR; PG8_MMA(0, 0, At, B0); PG8_MMA(0, 1, At, B1); PG8_BAR; PG8_SCHED;
            PG8_LDA(At, 0, 1); PG8_STAGE(PG8_SB(0, 0), b2, voffB); PG8_STAGE(PG8_SB(0, 1), b2 + hstep, voffB); PG8_STAGE(PG8_SA(0, 0), a2, voffA);
            PG8_WAIT_V(8); PG8_WAIT_L(0); PG8_BAR; PG8_MMA(1, 0, At, B0); PG8_MMA(1, 1, At, B1); PG8_BAR; PG8_SCHED;
            PG8_LDB(B0, 1, 0); PG8_LDB(B1, 1, 1); PG8_SCHED; PG8_LDA(At, 1, 0); PG8_STAGE(PG8_SA(0, 1), a2 + hstep, voffA);
            PG8_WAIT_V(8); PG8_WAIT_L(0); PG8_BAR; PG8_MMA(0, 0, At, B0); PG8_MMA(0, 1, At, B1); PG8_BAR; PG8_SCHED;
            PG8_LDA(At, 1, 1); PG8_STAGE(PG8_SB(1, 0), b3, voffB); PG8_STAGE(PG8_SB(1, 1), b3 + hstep, voffB); PG8_STAGE(PG8_SA(1, 0), a3, voffA);
            PG8_WAIT_V(8); PG8_WAIT_L(0); PG8_BAR; PG8_MMA(1, 0, At, B0); PG8_MMA(1, 1, At, B1); PG8_BAR; PG8_SCHED;
            } else {
            PG8_LDB(B0, 0, 0); PG8_SCHED; PG8_LDA(At, 0, 0); PG8_STAGE(PG8_SA(1, 1), a1 + hstep, voffA);
            PG8_WAIT_L(8); PG8_BAR; PG8_WAIT_L(0); PG8_MMA(0, 0, At, B0); PG8_BAR; PG8_SCHED;
            PG8_LDB(B1, 0, 1); PG8_STAGE(PG8_SB(0, 0), b2, voffB);
            PG8_BAR; PG8_WAIT_L(0); PG8_MMA(0, 1, At, B1); PG8_BAR;
            PG8_LDA(At, 0, 1); PG8_STAGE(PG8_SA(0, 0), a2, voffA);
            PG8_BAR; PG8_WAIT_L(0); PG8_MMA(1, 0, At, B0); PG8_BAR; PG8_SCHED;
            PG8_STAGE(PG8_SB(0, 1), b2 + hstep, voffB);
            PG8_WAIT_V(6); PG8_BAR; PG8_MMA(1, 1, At, B1); PG8_BAR;
            PG8_LDB(B0, 1, 0); PG8_SCHED; PG8_LDA(At, 1, 0); PG8_STAGE(PG8_SA(0, 1), a2 + hstep, voffA);
            PG8_WAIT_L(8); PG8_BAR; PG8_WAIT_L(0); PG8_MMA(0, 0, At, B0); PG8_BAR; PG8_SCHED;
            PG8_LDB(B1, 1, 1); PG8_STAGE(PG8_SB(1, 0), b3, voffB);
            PG8_BAR; PG8_WAIT_L(0); PG8_MMA(0, 1, At, B1); PG8_BAR;
            PG8_LDA(At, 1, 1); PG8_STAGE(PG8_SA(1, 0), a3, voffA);
            PG8_BAR; PG8_WAIT_L(0); PG8_MMA(1, 0, At, B0); PG8_BAR; PG8_SCHED;
            PG8_STAGE(PG8_SB(1, 1), b3 + hstep, voffB);
            PG8_WAIT_V(6); PG8_BAR; PG8_MMA(1, 1, At, B1); PG8_BAR;
            }
        }
        if constexpr (ALIGN_EPI) { if (wr == 0) PG8_BAR; }
        if constexpr (!Epi::AFTER_DRAIN) { E(acc, cur, wr, wc, fr, fq); S.done(cur); }
        if (!has_next) break;
#pragma unroll
        for (int a = 0; a < 2; ++a)
#pragma unroll
            for (int b = 0; b < 2; ++b)
#pragma unroll
                for (int m = 0; m < 4; ++m)
#pragma unroll
                    for (int n = 0; n < 2; ++n) acc[a][b][m][n] = (f32x4){0.f, 0.f, 0.f, 0.f};
        cur = nxt; cA = nA; cB = nB; ++ui;
        if constexpr (ALIGN_EPI) { if (wr == 1) PG8_BAR; }
    }
    PG8_WAIT_V(0);
    if constexpr (!ALIGN_EPI) { if (wr == 0) PG8_BAR; }
    PG8_BAR;
    if constexpr (Epi::AFTER_DRAIN) { E.fused(acc, cur, wr, wc, fr, fq, lds, wid, lane); S.done(cur); }
#undef PG8_SA
#undef PG8_SB
#undef PG8_STAGE
#undef PG8_LDA
#undef PG8_LDB
#undef PG8_MMA
#undef PG8_WAIT_V
#undef PG8_WAIT_L
#undef PG8_BAR
#undef PG8_SCHED
}
}

namespace pg8 {
struct UnitG : Unit { int e; };
template <class Epi, class Sched>
__device__ __forceinline__ void gemm_phase_g(PG8_LAS unsigned char* lds, const int K, const Sched& S, const Epi& E) {
    const int tid = threadIdx.x, wid = __builtin_amdgcn_readfirstlane(tid >> 6), lane = tid & 63, wr = wid >> 2, wc = wid & 3, fr = lane & 15, fq = lane >> 4;
    const int nt = K / BK;
    unsigned voffB[2];
#pragma unroll
    for (int i = 0; i < 2; ++i) { int R, C; stage_rc(tid * 16 + i * 8192, R, C); const int Rb = Epi::PERM ? ((R & ~31) + perm32(R & 31)) : R;
        voffB[i] = (unsigned)(Rb * K + C) * 2u; }
    const size_t kstep = (size_t)(BK * 2);
    const size_t hstep = (size_t)HALF * K * 2;
    const unsigned ldsw = (unsigned)wid * 1024u;
    const int aoff = lds_byte(wr * 64 + fr, fq * 8), boff = lds_byte(wc * 32 + fr, fq * 8);
#define PG8_SA(b, h) (((b) * 2 + (h)) * HTB)
#define PG8_SB(b, h) ((4 + (b) * 2 + (h)) * HTB)
#define PG8_STAGE(bufoff, gbase, voff) do { _Pragma("unroll") for (int _i = 0; _i < 2; ++_i) \
        __builtin_amdgcn_global_load_lds((const unsigned*)((const char*)(gbase) + (voff)[_i]), (PG8_LAS unsigned*)(lds + (bufoff) + ldsw + _i * 8192), 16, 0, 0); } while (0)
#define PG8_LDA(dst, b, h) do { _Pragma("unroll") for (int m = 0; m < 4; ++m) _Pragma("unroll") for (int k = 0; k < 2; ++k) dst[m][k] = *(const PG8_LAS bf16x8*)(lds + PG8_SA(b, h) + aoff + m * 2048 + k * 1024); } while (0)
#define PG8_LDB(dst, b, h) do { _Pragma("unroll") for (int n = 0; n < 2; ++n) _Pragma("unroll") for (int k = 0; k < 2; ++k) dst[n][k] = *(const PG8_LAS bf16x8*)(lds + PG8_SB(b, h) + boff + n * 2048 + k * 1024); } while (0)
#define PG8_MMA(ai, bj, At, Bt) do { __builtin_amdgcn_s_setprio(1); _Pragma("unroll") for (int m = 0; m < 4; ++m) _Pragma("unroll") for (int n = 0; n < 2; ++n) _Pragma("unroll") for (int k = 0; k < 2; ++k) \
        acc[ai][bj][m][n] = __builtin_amdgcn_mfma_f32_16x16x32_bf16(Bt[n][k], At[m][k], acc[ai][bj][m][n], 0, 0, 0); __builtin_amdgcn_s_setprio(0); } while (0)
#define PG8_WAIT_V(n) asm volatile("s_waitcnt vmcnt(" #n ")" ::: "memory")
#define PG8_WAIT_L(n) asm volatile("s_waitcnt lgkmcnt(" #n ")" ::: "memory")
#define PG8_BAR __builtin_amdgcn_s_barrier()
#define PG8_SCHED __builtin_amdgcn_sched_barrier(0)
    UnitG cur, nxt; int ui = 0;
    if (!S.next(0, cur)) return;
    f32x4 acc[2][2][4][2];
#pragma unroll
    for (int a = 0; a < 2; ++a)
#pragma unroll
        for (int b = 0; b < 2; ++b)
#pragma unroll
            for (int m = 0; m < 4; ++m)
#pragma unroll
                for (int n = 0; n < 2; ++n) acc[a][b][m][n] = (f32x4){0.f, 0.f, 0.f, 0.f};
    bf16x8 At[4][2], B0[2][2], B1[2][2];
    const char* cA = S.a_base(cur); const char* cB = S.b_base(cur);
    unsigned vA0[2], vA1[2];
#pragma unroll
    for (int i = 0; i < 2; ++i) { int R, C; stage_rc(tid * 16 + i * 8192, R, C); vA0[i] = S.a_voff(cur, R, C, 0); vA1[i] = S.a_voff(cur, R, C, 1); }
    PG8_STAGE(PG8_SB(0, 0), cB, voffB); PG8_STAGE(PG8_SB(0, 1), cB + hstep, voffB); PG8_STAGE(PG8_SA(0, 0), cA, vA0); PG8_STAGE(PG8_SA(0, 1), cA, vA1);
    if (wr == 1) PG8_BAR;
    PG8_WAIT_V(2); PG8_BAR;
    PG8_STAGE(PG8_SB(1, 0), cB + kstep, voffB); PG8_STAGE(PG8_SA(1, 0), cA + kstep, vA0); PG8_STAGE(PG8_SB(1, 1), cB + hstep + kstep, voffB);
    PG8_WAIT_V(6); PG8_BAR;
    for (;;) {
        const bool has_next = S.next(ui + 1, nxt);
        const char* nA = has_next ? S.a_base(nxt) : cA; const char* nB = has_next ? S.b_base(nxt) : cB;
#pragma unroll 1
        for (int t = 0; t < nt; t += 2) {
            const bool last = (t == nt - 2);
            const char* a1 = cA + (size_t)(t + 1) * kstep;
            const char* a2 = last ? nA : cA + (size_t)(t + 2) * kstep; const char* b2 = last ? nB : cB + (size_t)(t + 2) * kstep;
            const char* a3 = a2 + kstep; const char* b3 = b2 + kstep;
            unsigned sA0[2], sA1[2];
#pragma unroll
            for (int i = 0; i < 2; ++i) { sA0[i] = vA0[i]; sA1[i] = vA1[i]; }
            if (last && has_next) {
#pragma unroll
                for (int i = 0; i < 2; ++i) { int R, C; stage_rc(tid * 16 + i * 8192, R, C); sA0[i] = S.a_voff(nxt, R, C, 0); sA1[i] = S.a_voff(nxt, R, C, 1); }
            }
            PG8_LDB(B0, 0, 0); PG8_LDB(B1, 0, 1); PG8_SCHED; PG8_LDA(At, 0, 0); PG8_STAGE(PG8_SA(1, 1), a1, vA1);
            PG8_WAIT_V(8); PG8_WAIT_L(0); PG8_BAR; PG8_MMA(0, 0, At, B0); PG8_MMA(0, 1, At, B1); PG8_BAR; PG8_SCHED;
            PG8_LDA(At, 0, 1); PG8_STAGE(PG8_SB(0, 0), b2, voffB); PG8_STAGE(PG8_SB(0, 1), b2 + hstep, voffB); PG8_STAGE(PG8_SA(0, 0), a2, sA0);
            PG8_WAIT_V(8); PG8_WAIT_L(0); PG8_BAR; PG8_MMA(1, 0, At, B0); PG8_MMA(1, 1, At, B1); PG8_BAR; PG8_SCHED;
            PG8_LDB(B0, 1, 0); PG8_LDB(B1, 1, 1); PG8_SCHED; PG8_LDA(At, 1, 0); PG8_STAGE(PG8_SA(0, 1), a2, sA1);
            PG8_WAIT_V(8); PG8_WAIT_L(0); PG8_BAR; PG8_MMA(0, 0, At, B0); PG8_MMA(0, 1, At, B1); PG8_BAR; PG8_SCHED;
            PG8_LDA(At, 1, 1); PG8_STAGE(PG8_SB(1, 0), b3, voffB); PG8_STAGE(PG8_SB(1, 1), b3 + hstep, voffB); PG8_STAGE(PG8_SA(1, 0), a3, sA0);
            PG8_WAIT_V(8); PG8_WAIT_L(0); PG8_BAR; PG8_MMA(1, 0, At, B0); PG8_MMA(1, 1, At, B1); PG8_BAR; PG8_SCHED;
        }
        if (wr == 0) PG8_BAR;
        E(acc, cur, wr, wc, fr, fq);
        if (!has_next) break;
#pragma unroll
        for (int a = 0; a < 2; ++a)
#pragma unroll
            for (int b = 0; b < 2; ++b)
#pragma unroll
                for (int m = 0; m < 4; ++m)
#pragma unroll
                    for (int n = 0; n < 2; ++n) acc[a][b][m][n] = (f32x4){0.f, 0.f, 0.f, 0.f};
        cur = nxt; cA = nA; cB = nB; ++ui;
#pragma unroll
        for (int i = 0; i < 2; ++i) { int R, C; stage_rc(tid * 16 + i * 8192, R, C); vA0[i] = S.a_voff(cur, R, C, 0); vA1[i] = S.a_voff(cur, R, C, 1); }
        if (wr == 1) PG8_BAR;
    }
    PG8_WAIT_V(0);
    PG8_BAR;
#undef PG8_SA
#undef PG8_SB
#undef PG8_STAGE
#undef PG8_LDA
#undef PG8_LDB
#undef PG8_MMA
#undef PG8_WAIT_V
#undef PG8_WAIT_L
#undef PG8_BAR
#undef PG8_SCHED
}
}

namespace pg8 {
typedef unsigned u32x2 __attribute__((ext_vector_type(2)));
typedef __bf16 bf16x2_t __attribute__((ext_vector_type(2)));
typedef float f32x2_t __attribute__((ext_vector_type(2)));
__device__ __forceinline__ unsigned cvt_pk_bf16(float lo, float hi) { f32x2_t v = {lo, hi}; bf16x2_t r = __builtin_convertvector(v, bf16x2_t); return __builtin_bit_cast(unsigned, r); }
__device__ __forceinline__ float fast_sigmoid(float x) { return __builtin_amdgcn_rcpf(1.f + __builtin_amdgcn_exp2f(-1.4426950408889634f * x)); }
__device__ __forceinline__ void store8(bf16_t* p, const f32x4& v0, const f32x4& v1) {
    u32x4 w; w.x = cvt_pk_bf16(v0[0], v0[1]); w.y = cvt_pk_bf16(v0[2], v0[3]); w.z = cvt_pk_bf16(v1[0], v1[1]); w.w = cvt_pk_bf16(v1[2], v1[3]); *(u32x4*)p = w;
}
__device__ __forceinline__ float log2_gamma(int h) { return h == 0 ? -0.045803689613124944f : (h == 1 ? -0.022720076500083580f : (h == 2 ? -0.011315313227834146f : -0.005646563141142063f)); }

struct EpiProj {
    static constexpr bool PERM = true, AFTER_DRAIN = false;
    bf16_t *upool, *q, *k, *v, *g, *xq, *gates; const float* cs;
    template <int KIND>
    __device__ __forceinline__ void run(const f32x4 (&acc)[2][2][4][2], bf16_t* base, int ld, int colt, int pm, int hbase, int wr, int wc, int fr, int fq) const {
        const int row0 = pm * BM + wr * 64 + fr, lc = wc * 32 + 8 * fq;
#pragma unroll
        for (int ai = 0; ai < 2; ++ai)
#pragma unroll
            for (int m = 0; m < 4; ++m) {
                const int row = row0 + ai * HALF + m * 16;
                bf16_t* rowp = base + (size_t)row * ld + colt + lc;
                f32x4 c0, c1;
                if (KIND >= 4) { const f32x4* cp = (const f32x4*)(cs + ((size_t)row * 64 + (lc >> 1)) * 2); c0 = cp[0]; c1 = cp[1]; }
#pragma unroll
                for (int bj = 0; bj < 2; ++bj) {
                    f32x4 v0 = acc[ai][bj][m][0], v1 = acc[ai][bj][m][1];
                    if (KIND == 1) { for (int e = 0; e < 4; ++e) { v0[e] = v0[e] * fast_sigmoid(v0[e]); v1[e] = v1[e] * fast_sigmoid(v1[e]); } }
                    else if (KIND == 2) { v0 = v0 * 0.08838834764831845f; v1 = v1 * 0.08838834764831845f; }
                    else if (KIND == 3) { for (int e = 0; e < 4; ++e) { v0[e] = fast_sigmoid(v0[e]); v1[e] = fast_sigmoid(v1[e]); } }
                    else if (KIND >= 4) {
                        const float cpos = (float)(row & (CH - 1)), l2g = log2_gamma(hbase + bj);
                        const float sc = (KIND == 4) ? __builtin_amdgcn_exp2f(cpos * l2g) : 0.08838834764831845f * __builtin_amdgcn_exp2f(-cpos * l2g);
                        f32x4 r0, r1;
                        r0[0] = (v0[0] * c0[0] - v0[1] * c0[1]) * sc; r0[1] = (v0[1] * c0[0] + v0[0] * c0[1]) * sc;
                        r0[2] = (v0[2] * c0[2] - v0[3] * c0[3]) * sc; r0[3] = (v0[3] * c0[2] + v0[2] * c0[3]) * sc;
                        r1[0] = (v1[0] * c1[0] - v1[1] * c1[1]) * sc; r1[1] = (v1[1] * c1[0] + v1[0] * c1[1]) * sc;
                        r1[2] = (v1[2] * c1[2] - v1[3] * c1[3]) * sc; r1[3] = (v1[3] * c1[2] + v1[2] * c1[3]) * sc;
                        v0 = r0; v1 = r1;
                    }
                    store8(rowp + bj * HALF, v0, v1);
                }
            }
    }
    __device__ __forceinline__ void operator()(const f32x4 (&acc)[2][2][4][2], const Unit& u, int wr, int wc, int fr, int fq) const {
        const int pn = u.pn;
        if (pn < 2) run<0>(acc, upool, 512, pn * 256, u.pm, 0, wr, wc, fr, fq);
        else if (pn < 4) run<4>(acc, q, 512, (pn - 2) * 256, u.pm, (pn - 2) * 2, wr, wc, fr, fq);
        else if (pn < 6) run<5>(acc, k, 512, (pn - 4) * 256, u.pm, (pn - 4) * 2, wr, wc, fr, fq);
        else if (pn < 10) run<0>(acc, v, 1024, (pn - 6) * 256, u.pm, 0, wr, wc, fr, fq);
        else if (pn < 14) run<1>(acc, g, 1024, (pn - 10) * 256, u.pm, 0, wr, wc, fr, fq);
        else if (pn < 16) run<2>(acc, xq, 512, (pn - 14) * 256, u.pm, 0, wr, wc, fr, fq);
        else {
            bf16_t* tp = gates + ((size_t)(u.pm * 12 + (pn - 16)) << 16) + (size_t)(((wr * 4 + wc) * 64 + fq * 16 + fr) * 8);
#pragma unroll
            for (int ai = 0; ai < 2; ++ai)
#pragma unroll
                for (int m = 0; m < 4; ++m)
#pragma unroll
                    for (int bj = 0; bj < 2; ++bj) { f32x4 v0 = acc[ai][bj][m][0], v1 = acc[ai][bj][m][1];
#pragma unroll
                        for (int q = 0; q < 4; ++q) { v0[q] = fast_sigmoid(v0[q]); v1[q] = fast_sigmoid(v1[q]); }
                        store8(tp + (((ai * 4 + m) * 2 + bj) << 12), v0, v1); }
        }
    }
};
}

namespace pg8 {
struct EpiMemKV {
    static constexpr bool PERM = true, AFTER_DRAIN = false;
    bf16_t *mk, *mv;
    __device__ __forceinline__ void operator()(const f32x4 (&acc)[2][2][4][2], const Unit& u, int wr, int wc, int fr, int fq) const {
        bf16_t* base = u.pn < 2 ? mk : mv; const int colt = (u.pn & 1) * 256;
        const int row0 = u.pm * BM + wr * 64 + fr, lc = wc * 32 + 8 * fq;
#pragma unroll
        for (int ai = 0; ai < 2; ++ai)
#pragma unroll
            for (int m = 0; m < 4; ++m) { bf16_t* rowp = base + (size_t)(row0 + ai * HALF + m * 16) * 512 + colt + lc;
#pragma unroll
                for (int bj = 0; bj < 2; ++bj) store8(rowp + bj * HALF, acc[ai][bj][m][0], acc[ai][bj][m][1]); }
    }
};
struct EpiPoolMap {
    static constexpr bool PERM = true, AFTER_DRAIN = false;
    bf16_t* ypool; const float* scale;
    __device__ __forceinline__ void operator()(const f32x4 (&acc)[2][2][4][2], const Unit& u, int wr, int wc, int fr, int fq) const {
        const int row0 = u.pm * BM + wr * 64 + fr, col0 = u.pn * 256 + wc * 32 + 8 * fq;
        f32x4 s[2][2];
#pragma unroll
        for (int bj = 0; bj < 2; ++bj) { s[bj][0] = *(const f32x4*)(scale + col0 + bj * HALF); s[bj][1] = *(const f32x4*)(scale + col0 + bj * HALF + 4); }
#pragma unroll
        for (int ai = 0; ai < 2; ++ai)
#pragma unroll
            for (int m = 0; m < 4; ++m) { bf16_t* rowp = ypool + (size_t)(row0 + ai * HALF + m * 16) * 512 + col0;
#pragma unroll
                for (int bj = 0; bj < 2; ++bj) store8(rowp + bj * HALF, acc[ai][bj][m][0] * s[bj][0], acc[ai][bj][m][1] * s[bj][1]); }
    }
};
__device__ __forceinline__ f32x4 bf4_to_f32(unsigned lo, unsigned hi) {
    f32x4 r; r[0] = __uint_as_float(lo << 16); r[1] = __uint_as_float(lo & 0xffff0000u); r[2] = __uint_as_float(hi << 16); r[3] = __uint_as_float(hi & 0xffff0000u); return r;
}
struct EpiGate {
    static constexpr bool PERM = true, AFTER_DRAIN = false;
    bf16_t* merged; bf16_t* part; const bf16_t* gates; int sel; int step;
    __device__ __forceinline__ void operator()(const f32x4 (&acc)[2][2][4][2], const Unit& u, int wr, int wc, int fr, int fq) const {
        const int row0 = u.pm * BM + wr * 64 + fr, col0 = u.pn * 256 + wc * 32 + 8 * fq;
        const size_t lo = (size_t)(((wr * 4 + wc) * 64 + fq * 16 + fr) * 8);
        const bf16_t* gp = gates + ((size_t)(u.pm * 12 + sel * 4 + u.pn) << 16) + lo;
        bf16_t* pp = part + ((size_t)(u.pm * 4 + u.pn) << 16) + lo;
#pragma unroll
        for (int ai = 0; ai < 2; ++ai)
#pragma unroll
            for (int m = 0; m < 4; ++m) {
#pragma unroll
                for (int bj = 0; bj < 2; ++bj) { const int fo = ((ai * 4 + m) * 2 + bj) << 12;
                    const u32x4 gw = *(const u32x4*)(gp + fo);
                    f32x4 v0 = acc[ai][bj][m][0] * bf4_to_f32(gw.x, gw.y), v1 = acc[ai][bj][m][1] * bf4_to_f32(gw.z, gw.w);
                    if (step) { const u32x4 pw = *(const u32x4*)(pp + fo); v0 += bf4_to_f32(pw.x, pw.y); v1 += bf4_to_f32(pw.z, pw.w); }
                    if (step < 2) store8(pp + fo, v0, v1);
                    else store8(merged + (size_t)(row0 + ai * HALF + m * 16) * 1024 + col0 + bj * HALF, v0, v1); }
                asm volatile("" ::: "memory"); }
    }
};
struct EpiResid {
    static constexpr bool PERM = true, AFTER_DRAIN = false;
    bf16_t* h; const float* x;
    __device__ __forceinline__ void operator()(const f32x4 (&acc)[2][2][4][2], const Unit& u, int wr, int wc, int fr, int fq) const {
        const int row0 = u.pm * BM + wr * 64 + fr, col0 = u.pn * 256 + wc * 32 + 8 * fq;
#pragma unroll
        for (int ai = 0; ai < 2; ++ai)
#pragma unroll
            for (int m = 0; m < 4; ++m) { const size_t o = (size_t)(row0 + ai * HALF + m * 16) * 1024 + col0;
#pragma unroll
                for (int bj = 0; bj < 2; ++bj) { const float* xp = x + o + bj * HALF;
                    store8(h + o + bj * HALF, *(const f32x4*)xp * ALPHA + acc[ai][bj][m][0], *(const f32x4*)(xp + 4) * ALPHA + acc[ai][bj][m][1]); }
                asm volatile("" ::: "memory"); }
    }
};
}

#define GAS __attribute__((address_space(1)))
#define LAS __attribute__((address_space(3)))
typedef unsigned v4u __attribute__((ext_vector_type(4)));
typedef unsigned v2u __attribute__((ext_vector_type(2)));
typedef float f32x4 __attribute__((ext_vector_type(4)));
typedef float f32x16 __attribute__((ext_vector_type(16)));
typedef short bf16x8 __attribute__((ext_vector_type(8)));
typedef short bf16x4 __attribute__((ext_vector_type(4)));
#define LDS_WAIT() asm volatile("s_waitcnt lgkmcnt(0)" ::: "memory")
#define VM_WAIT() asm volatile("s_waitcnt vmcnt(0)" ::: "memory")
__device__ __forceinline__ unsigned pk2(float lo, float hi) { return pg8::cvt_pk_bf16(lo, hi); }
constexpr int NWAVES = 8, NTHREADS = 512;
constexpr int RING_BYTES = 131072;
constexpr int MISC_OFF = 163840 - 256;
constexpr int LDS_BYTES = 163840;

#define XB_TMO      128
#define XB_XCNT(j)  (256  + 64 * (j))
#define XB_XSUB(j)  (1280 + 64 * (j))
#define XB_XGEN(j)  (2304 + 64 * (j))
#define XB_TOP      3328
#define XB_TOPGEN   3392
#define XCD_BAR_WORDS 3456
#define XB_SPIN_CAP (1u << 18)

__device__ __forceinline__ unsigned xb_ld(unsigned* p)              { return __hip_atomic_load(p, __ATOMIC_RELAXED, __HIP_MEMORY_SCOPE_AGENT); }
__device__ __forceinline__ unsigned xb_add(unsigned* p, unsigned v) { return __hip_atomic_fetch_add(p, v, __ATOMIC_RELAXED, __HIP_MEMORY_SCOPE_AGENT); }
__device__ __forceinline__ unsigned xb_xcc_id() { return (unsigned)__builtin_amdgcn_s_getreg((3 << 11) | 20) & 0xFu; }
#define XB_SPIN(cond, bar) do { unsigned _sp = 0; while (cond) { __builtin_amdgcn_s_sleep(1); \
    if ((++_sp & 255u) == 0u) { if (xb_ld(&(bar)[XB_TMO])) break; if (_sp > XB_SPIN_CAP) { atomicAdd(&(bar)[XB_TMO], 1u); break; } } } } while (0)

struct XcdBarrier {
    unsigned* bar; unsigned x;
    volatile LAS unsigned* st;
};

__device__ __forceinline__ XcdBarrier xcd_barrier_post(unsigned* bar, volatile LAS unsigned* st) {
    XcdBarrier b; b.bar = bar; b.x = xb_xcc_id(); b.st = st;
    if (threadIdx.x == 0) (void)xb_add(&bar[XB_XCNT(b.x)], 1u);
    return b;
}
__device__ __forceinline__ void xcd_barrier_complete(unsigned* bar, unsigned x, unsigned& nloc, unsigned& nx) {
    const unsigned G = gridDim.x * gridDim.y * gridDim.z;
    unsigned sum, cnt, mine, sp = 0u;
    for (;;) {
        sum = 0u; cnt = 0u; mine = 0u;
#pragma unroll
        for (unsigned j = 0; j < 16; ++j) { const unsigned c = xb_ld(&bar[XB_XCNT(j)]); sum += c; cnt += (c > 0u) ? 1u : 0u; mine = (j == x) ? c : mine; }
        if (sum == G) break;
        __builtin_amdgcn_s_sleep(1);
        if ((++sp & 255u) == 0u) { if (xb_ld(&bar[XB_TMO])) break; if (sp > XB_SPIN_CAP) { atomicAdd(&bar[XB_TMO], 1u); break; } }
    }
    nloc = mine > 0u ? mine : 1u; nx = cnt > 0u ? cnt : 1u;
}

__device__ __forceinline__ void xcd_barrier(const XcdBarrier& b) {
    asm volatile("s_waitcnt vmcnt(0)" ::: "memory");
    __syncthreads();
    if (threadIdx.x == 0) {
        unsigned* bar = b.bar;
        __builtin_amdgcn_s_waitcnt(0);
        unsigned nloc = b.st[0], nx = b.st[1];
        if (nloc == 0u) { xcd_barrier_complete(bar, b.x, nloc, nx); b.st[0] = nloc; b.st[1] = nx; }
        const unsigned old = xb_add(&bar[XB_XSUB(b.x)], 1u);
        const unsigned gen = old / nloc;
        if (old + 1u == (gen + 1u) * nloc) {
            __builtin_amdgcn_fence(__ATOMIC_RELEASE, "agent");
            asm volatile("s_waitcnt vmcnt(0)" ::: "memory");
            const unsigned og = xb_add(&bar[XB_TOP], 1u);
            const unsigned tg = og / nx;
            if (og + 1u == (tg + 1u) * nx) xb_add(&bar[XB_TOPGEN], 1u);
            else XB_SPIN(xb_ld(&bar[XB_TOPGEN]) == tg, bar);
            __builtin_amdgcn_fence(__ATOMIC_ACQUIRE, "agent");
            xb_add(&bar[XB_XGEN(b.x)], 1u);
            asm volatile("s_waitcnt vmcnt(0)" ::: "memory");
        } else {
            XB_SPIN(xb_ld(&bar[XB_XGEN(b.x)]) == gen, bar);
            __builtin_amdgcn_fence(__ATOMIC_ACQUIRE, "agent");
            asm volatile("s_waitcnt vmcnt(0)" ::: "memory");
        }
    }
    __syncthreads();
}

struct Args { const void* in[23]; float* out; unsigned char* ws; int ph_lo, ph_hi, li, pad; };
struct Ctx {
    LAS unsigned char* lds; int tid, lane, wave, G, vcu;
};
template <class F>
__device__ __forceinline__ void transpose_item(F colf, int ldw, bf16_t* WT, int K, int kb, int nb, LAS float* scr, int lane) {
    const int k0 = 64 * kb, n0 = 32 * nb;
    const float* cp = colf(n0 + (lane & 31)) + (size_t)k0 * ldw;
#pragma unroll 8
    for (int i = 0; i < 32; ++i) { const int kk = 2 * i + (lane >> 5); scr[kk * 33 + (lane & 31)] = cp[(size_t)kk * ldw]; }
    LDS_WAIT(); asm volatile("" ::: "memory");
    const int c = lane & 7;
#pragma unroll
    for (int j = 0; j < 4; ++j) { const int n = (lane >> 3) + 8 * j; const LAS float* s = scr + (8 * c) * 33 + n;
        v4u o; o.x = pk2(s[0 * 33], s[1 * 33]); o.y = pk2(s[2 * 33], s[3 * 33]); o.z = pk2(s[4 * 33], s[5 * 33]); o.w = pk2(s[6 * 33], s[7 * 33]);
        *(v4u*)(WT + (size_t)(n0 + n) * K + k0 + 8 * c) = o; }
    LDS_WAIT(); asm volatile("" ::: "memory");
}
template <class F>
__device__ __forceinline__ void transpose_item64(F colf, int ldw, bf16_t* WT, int K, int kb, int nb, LAS float* scr, int lane) {
    const int k0 = 64 * kb, n0 = 64 * nb, c4 = lane & 15;
    const float* cp = colf(n0 + 4 * c4) + (size_t)k0 * ldw;
#pragma unroll 8
    for (int i = 0; i < 16; ++i) { const int kk = 4 * i + (lane >> 4); const f32x4 v = *(const f32x4*)(cp + (size_t)kk * ldw);
        LAS float* s = scr + kk * 65 + 4 * c4; s[0] = v[0]; s[1] = v[1]; s[2] = v[2]; s[3] = v[3]; }
    LDS_WAIT(); asm volatile("" ::: "memory");
    const int c = lane & 7;
#pragma unroll
    for (int j = 0; j < 8; ++j) { const int n = (lane >> 3) + 8 * j; const LAS float* s = scr + (8 * c) * 65 + n;
        v4u o; o.x = pk2(s[0 * 65], s[1 * 65]); o.y = pk2(s[2 * 65], s[3 * 65]); o.z = pk2(s[4 * 65], s[5 * 65]); o.w = pk2(s[6 * 65], s[7 * 65]);
        *(v4u*)(WT + (size_t)(n0 + n) * K + k0 + 8 * c) = o; }
    LDS_WAIT(); asm volatile("" ::: "memory");
}
struct ColPlain { const float* w; __device__ __forceinline__ const float* operator()(int n) const { return w + n; } };
struct ColWin {
    const float* w;
    __device__ __forceinline__ const float* operator()(int n) const {
        int src = n;
        if (n >= 512 && n < 1536) { const int r = (n - 512) & 511, sec = (n - 512) >> 9, hh = r >> 7, p = r & 127; src = 512 + sec * 512 + hh * 128 + (p >> 1) + 64 * (p & 1); }
        return w + src;
    }
};
__device__ __forceinline__ void f32_to_bf16_range(const float* in, bf16_t* out, size_t n4, size_t gtid, size_t nthr) {
    for (size_t i = gtid; i < n4; i += nthr) { const f32x4 v = ((const f32x4*)in)[i]; v2u o; o.x = pk2(v[0], v[1]); o.y = pk2(v[2], v[3]); ((v2u*)out)[i] = o; }
}
__device__ __forceinline__ void p0_prologue(const Ctx& C, const Args& a) {
    const float* x = (const float*)a.in[0]; const float* mem = (const float*)a.in[1]; const int* positions = (const int*)a.in[2];
    const float* w_in = (const float*)a.in[3]; const float* w_pool_grp = (const float*)a.in[4]; const float* w_mem_kv = (const float*)a.in[7];
    const float* w_br_pool = (const float*)a.in[8]; const float* w_br_ret = (const float*)a.in[9]; const float* w_br_xa = (const float*)a.in[10]; const float* w_out = (const float*)a.in[11];
    unsigned char* dout = (unsigned char*)a.out; unsigned char* ws = a.ws;
    LAS float* scr = (LAS float*)(C.lds + C.wave * 16640);
    const int gw = C.vcu * NWAVES + C.wave, NGW = C.G * NWAVES;
    constexpr int I_WA = 16 * 8, I_WQK = 16 * 32, I_WB = 16 * 88, I_WMEM = 16 * 16, I_WP = 8 * 16, I_WR = 16 * 16, I_WX = 8 * 16, I_WO = 16 * 16;
    constexpr int NITEMS = I_WA + I_WQK + I_WB + I_WMEM + I_WP + I_WR + I_WX + I_WO;
    for (int it = gw; it < NITEMS; it += NGW) {
        int r = it;
        if (r < I_WA) { transpose_item64(ColPlain{w_in}, NIN, (bf16_t*)(dout + DO_WINT), 1024, r / 8, r % 8, scr, C.lane); continue; } r -= I_WA;
        if (r < I_WQK) { transpose_item(ColWin{w_in}, NIN, (bf16_t*)(dout + DO_WINT), 1024, r / 32, 16 + r % 32, scr, C.lane); continue; } r -= I_WQK;
        if (r < I_WB) { transpose_item64(ColPlain{w_in}, NIN, (bf16_t*)(dout + DO_WINT), 1024, r / 88, 24 + r % 88, scr, C.lane); continue; } r -= I_WB;
        if (r < I_WMEM) { transpose_item64(ColPlain{w_mem_kv}, 1024, (bf16_t*)(ws + WS_WMEMT), 1024, r / 16, r % 16, scr, C.lane); continue; } r -= I_WMEM;
        if (r < I_WP) { transpose_item64(ColPlain{w_br_pool}, 1024, (bf16_t*)(ws + WS_WPT), 512, r / 16, r % 16, scr, C.lane); continue; } r -= I_WP;
        if (r < I_WR) { transpose_item64(ColPlain{w_br_ret}, 1024, (bf16_t*)(ws + WS_WRT), 1024, r / 16, r % 16, scr, C.lane); continue; } r -= I_WR;
        if (r < I_WX) { transpose_item64(ColPlain{w_br_xa}, 1024, (bf16_t*)(ws + WS_WXT), 512, r / 16, r % 16, scr, C.lane); continue; } r -= I_WX;
        transpose_item64(ColPlain{w_out}, 1024, (bf16_t*)(ws + WS_WOUTT), 1024, r / 16, r % 16, scr, C.lane);
    }
    const size_t gtid = (size_t)C.vcu * NTHREADS + C.tid, nthr = (size_t)C.G * NTHREADS;
    f32_to_bf16_range(x, (bf16_t*)(dout + DO_XB), (size_t)T * 1024 / 4, gtid, nthr);
    f32_to_bf16_range(mem, (bf16_t*)(ws + WS_MEMB), (size_t)BATCH * MEML * 1024 / 4, gtid, nthr);
    { bf16_t* wbd = (bf16_t*)(ws + WS_WPOOLBD);
      for (size_t i = gtid; i < 512 * 512; i += nthr) { const int n = (int)(i >> 9), k = (int)(i & 511);
          wbd[i] = ((n >> 7) == (k >> 7)) ? f2bf(w_pool_grp[((size_t)(n >> 7) * 128 + (k & 127)) * 128 + (n & 127)]) : (bf16_t)0; } }
    { float* cs = (float*)(dout + DO_CS); const int j = (int)(gtid & 63);
      const double invf = (double)(float)pow(10000.0, -(double)j / 64.0);
      for (size_t i = gtid; i < (size_t)T * 64; i += nthr) { const int t = (int)(i >> 6); const double ang = (double)positions[t] * invf;
          cs[2 * i] = (float)cos(ang); cs[2 * i + 1] = (float)sin(ang); } }
}

namespace pg8 {
template <bool GATHER> struct MoeSched {
    const PG8_LAS int* base;
    const int* cnt; const int* lists;
    const char* A; const char* Bt; size_t b_estride;
    int K, NP, G, c;
    __device__ __forceinline__ bool next(int i, UnitG& u) const {
        const int ntr = base[32] >> 8, L = i * G + c;
        if (L >= ntr * NP) return false;
        const int rt = L / NP;
        u.pm = rt; u.pn = L - rt * NP; u.e = base[40 + rt]; return true;
    }
    __device__ __forceinline__ const char* a_base(const UnitG& u) const { return GATHER ? A : A + (size_t)u.pm * 256 * K * 2; }
    __device__ __forceinline__ const char* b_base(const UnitG& u) const { return Bt + (size_t)u.e * b_estride + (size_t)u.pn * 256 * K * 2; }
    __device__ __forceinline__ unsigned a_voff(const UnitG& u, int R, int C, int half) const {
        if (!GATHER) return (unsigned)((half * 128 + R) * K + C) * 2u;
        const int slot = u.pm * 256 + half * 128 + R - base[u.e], n = cnt[u.e];
        const int tok = lists[(size_t)u.e * T + (slot < n ? slot : 0)];
        return (unsigned)(tok * K + C) * 2u;
    }
};
struct MoeOrder {
    const PG8_LAS int* base; int NP, G, c;
    __device__ __forceinline__ bool next(int i, Unit& u) const {
        const int ntr = base[32] >> 8, L = i * G + c;
        if (L >= ntr * NP) return false;
        const int rt = L / NP, e = base[40 + rt];
        u.pm = rt; u.pn = e * NP + (L - rt * NP); return true;
    }
    __device__ __forceinline__ void a_ready(const Unit&) const {}
    __device__ __forceinline__ void done(const Unit&) const {}
};
struct EpiMoeAct {
    static constexpr bool PERM = true, AFTER_DRAIN = false;
    bf16_t* act;
    __device__ __forceinline__ void operator()(const f32x4 (&acc)[2][2][4][2], const Unit& u, int wr, int wc, int fr, int fq) const {
        const int row0 = u.pm * BM + wr * 64 + fr, f0 = u.pn * 128 + wc * 32 + 8 * fq;
#pragma unroll
        for (int ai = 0; ai < 2; ++ai)
#pragma unroll
            for (int m = 0; m < 4; ++m) { f32x4 o0, o1;
#pragma unroll
                for (int e = 0; e < 4; ++e) { const float g0 = acc[ai][0][m][0][e], g1 = acc[ai][0][m][1][e];
                    o0[e] = g0 * fast_sigmoid(g0) * acc[ai][1][m][0][e]; o1[e] = g1 * fast_sigmoid(g1) * acc[ai][1][m][1][e]; }
                store8(act + (size_t)(row0 + ai * HALF + m * 16) * 256 + f0, o0, o1); }
    }
};
struct EpiMoeY {
    static constexpr bool PERM = true, AFTER_DRAIN = false;
    bf16_t* y;
    __device__ __forceinline__ void operator()(const f32x4 (&acc)[2][2][4][2], const Unit& u, int wr, int wc, int fr, int fq) const {
        const int row0 = u.pm * BM + wr * 64 + fr, col0 = (u.pn & 3) * 256 + wc * 32 + 8 * fq;
#pragma unroll
        for (int ai = 0; ai < 2; ++ai)
#pragma unroll
            for (int m = 0; m < 4; ++m) { bf16_t* rowp = y + (size_t)(row0 + ai * HALF + m * 16) * 1024 + col0;
#pragma unroll
                for (int bj = 0; bj < 2; ++bj) store8(rowp + bj * HALF, acc[ai][bj][m][0], acc[ai][bj][m][1]); }
    }
};
}
struct ColMoe1 {
    unsigned long long wg, delta;
    __device__ __forceinline__ const float* operator()(int n) const { const unsigned long long p = wg + (((n >> 7) & 1) ? delta : 0ull); return (const float*)p + (n >> 8) * 128 + (n & 127); }
};
__device__ __forceinline__ void moe_convert_weights(const Ctx& C, const Args& a) {
    const float* w_eg = (const float*)a.in[18]; const float* w_eu = (const float*)a.in[19]; const float* w_ed = (const float*)a.in[20];
    bf16_t* w1 = (bf16_t*)(a.ws + WS_MOEW1); bf16_t* w2 = (bf16_t*)(a.ws + WS_MOEW2);
    LAS float* scr = (LAS float*)(C.lds + C.wave * 16640);
    const int gw = C.vcu * NWAVES + C.wave, NGW = C.G * NWAVES;
    for (int it = gw; it < 6144; it += NGW) {
        if (it < 4096) { const int e = it >> 7, r = it & 127;
            transpose_item64(ColMoe1{(unsigned long long)(w_eg + (size_t)e * 262144), (unsigned long long)w_eu - (unsigned long long)w_eg}, 256, w1 + (size_t)e * 524288, 1024, r >> 3, r & 7, scr, C.lane); }
        else { const int r = it - 4096, e = r >> 6, rr = r & 63;
            transpose_item64(ColPlain{w_ed + (size_t)e * 262144}, 1024, w2 + (size_t)e * 262144, 256, rr >> 4, rr & 15, scr, C.lane); }
    }
}
__device__ __forceinline__ void compute_base(const Ctx& C, const int* cnt, LAS int* base) {
    if (C.wave == 0) {
        const int c = C.lane < 32 ? cnt[C.lane] : 0, p = (c + 255) & ~255; int incl = p;
#pragma unroll
        for (int o = 1; o < 32; o <<= 1) { const int t = __shfl_up(incl, o); if (C.lane >= o) incl += t; }
        if (C.lane < 32) base[C.lane] = incl - p;
        if (C.lane == 31) base[32] = incl;
    }
    __syncthreads();
    if (C.tid < 160) { const int r0 = C.tid << 8; int e = 0;
#pragma unroll 1
        for (int j = 1; j < 32; ++j) e = (base[j] <= r0) ? j : e;
        base[40 + C.tid] = e; }
    __syncthreads();
}

struct TokInfo { int e0, e1, s0, s1; float w0, w1; int pad0, pad1; };
#define DPP_ADD(v, ctrl) ((v) + __builtin_bit_cast(float, __builtin_amdgcn_mov_dpp(__builtin_bit_cast(int, (v)), (ctrl), 0xf, 0xf, true)))
__device__ __forceinline__ float wave_sum(float v) {
    v = DPP_ADD(v, 0xB1);
    v = DPP_ADD(v, 0x4E);
    v = DPP_ADD(v, 0x124);
    v = DPP_ADD(v, 0x128);
    const int b = __builtin_bit_cast(int, v);
    return (__builtin_bit_cast(float, __builtin_amdgcn_readlane(b, 0)) + __builtin_bit_cast(float, __builtin_amdgcn_readlane(b, 16)))
         + (__builtin_bit_cast(float, __builtin_amdgcn_readlane(b, 32)) + __builtin_bit_cast(float, __builtin_amdgcn_readlane(b, 48)));
}
constexpr int RW_STRIDE = 1024;
__device__ __forceinline__ void route_assign(const Ctx& C, LAS int* wb, int n, int* cnt, int* lists, TokInfo* info) {
    LAS int* lcnt = (LAS int*)(C.lds + 147456 + 8192); LAS int* gbl = lcnt + 32;
    const int lane = C.lane, i = lane >> 1, kk = lane & 1;
    asm volatile("s_waitcnt lgkmcnt(0)" ::: "memory");
    int mye = 0, mys = 0;
    if (lane < 2 * n) { mye = wb[i * 8 + kk]; mys = __hip_atomic_fetch_add(lcnt + mye, 1, __ATOMIC_RELAXED, __HIP_MEMORY_SCOPE_WORKGROUP); }
    __syncthreads();
    if (C.tid < 32) gbl[C.tid] = atomicAdd(&cnt[C.tid], lcnt[C.tid]);
    __syncthreads();
    if (lane < 2 * n) { const int s = gbl[mye] + mys; lists[mye * T + s] = wb[i * 8 + 4]; wb[i * 8 + 5 + kk] = s; }
    asm volatile("s_waitcnt lgkmcnt(0)" ::: "memory");
    if (lane < n) { TokInfo ti; ti.e0 = wb[lane * 8]; ti.e1 = wb[lane * 8 + 1]; ti.w0 = __int_as_float(wb[lane * 8 + 2]); ti.w1 = __int_as_float(wb[lane * 8 + 3]);
        ti.s0 = wb[lane * 8 + 5]; ti.s1 = wb[lane * 8 + 6]; ti.pad0 = 0; ti.pad1 = 0; info[wb[lane * 8 + 4]] = ti; }
}
__device__ __forceinline__ void p5_stage_router(const Ctx& C, const Args& a) {
    float* hx = a.out; bf16_t* x1b = (bf16_t*)(a.ws + WS_X1B);
    const float* ln_w = (const float*)a.in[12]; const float* ln_b = (const float*)a.in[13];
    const float* wgr = (const float*)a.in[14]; const float* bgr = (const float*)a.in[15]; const float* wer = (const float*)a.in[16]; const float* ber = (const float*)a.in[17];
    int* cnt = (int*)(a.ws + WS_CTL) + CW_CNT; int* lists = (int*)(a.ws + WS_LISTS); TokInfo* info = (TokInfo*)(a.ws + WS_TOKINFO);
    LAS float* Wl = (LAS float*)C.lds;
    for (int i = C.tid; i < 1024; i += NTHREADS) { const f32x4 w = *(const f32x4*)(wgr + 4 * i);
#pragma unroll
        for (int j = 0; j < 4; ++j) Wl[j * RW_STRIDE + i] = w[j]; }
    for (int i = C.tid; i < 8192; i += NTHREADS) { const int k = i >> 3, j4 = (i & 7) * 4; const f32x4 w = *(const f32x4*)(wer + 4 * i);
#pragma unroll
        for (int j = 0; j < 4; ++j) Wl[(4 + j4 + j) * RW_STRIDE + k] = w[j]; }
    if (C.tid < 64) ((LAS int*)(C.lds + 147456 + 8192))[C.tid] = 0;
    __syncthreads();
}
__device__ __forceinline__ void p5_ln1_router(const Ctx& C, const Args& a) {
    const bf16_t* hb = (const bf16_t*)a.out; bf16_t* x1b = (bf16_t*)(a.ws + WS_X1B);
    const float* ln_w = (const float*)a.in[12]; const float* ln_b = (const float*)a.in[13];
    const float* bgr = (const float*)a.in[15]; const float* ber = (const float*)a.in[17];
    int* cnt = (int*)(a.ws + WS_CTL) + CW_CNT; int* lists = (int*)(a.ws + WS_LISTS); TokInfo* info = (TokInfo*)(a.ws + WS_TOKINFO);
    LAS float* Wl = (LAS float*)C.lds;
    const int lane = C.lane;
    f32x4 lw[4], lb[4];
#pragma unroll
    for (int q = 0; q < 4; ++q) { lw[q] = *(const f32x4*)(ln_w + 256 * q + 4 * lane); lb[q] = *(const f32x4*)(ln_b + 256 * q + 4 * lane); }
    const int gw = C.vcu * NWAVES + C.wave, NGW = C.G * NWAVES;
    v2u vn[4];
    if (gw < T) {
#pragma unroll
        for (int q = 0; q < 4; ++q) vn[q] = *(const v2u*)(hb + (size_t)gw * 1024 + 256 * q + 4 * lane);
    }
    LAS int* wb = (LAS int*)(C.lds + 147456 + C.wave * 1024); int nb = 0;
    for (int t = gw; t < T; t += NGW) {
        const bf16_t* row = hb + (size_t)t * 1024;
        f32x4 v[4]; float s = 0.f;
#pragma unroll
        for (int q = 0; q < 4; ++q) { v[q] = pg8::bf4_to_f32(vn[q].x, vn[q].y); s += (v[q][0] + v[q][1]) + (v[q][2] + v[q][3]); }
        if (t + NGW < T) {
#pragma unroll
            for (int q = 0; q < 4; ++q) vn[q] = *(const v2u*)(row + (size_t)NGW * 1024 + 256 * q + 4 * lane);
        }
        const float mu = wave_sum(s) * (1.f / 1024.f); float sq = 0.f;
#pragma unroll
        for (int q = 0; q < 4; ++q) { v[q] = v[q] - mu; sq += (v[q][0] * v[q][0] + v[q][1] * v[q][1]) + (v[q][2] * v[q][2] + v[q][3] * v[q][3]); }
        const float rstd = rsqrtf(wave_sum(sq) * (1.f / 1024.f) + LN_EPS);
#pragma unroll
        for (int q = 0; q < 4; ++q) { v[q] = v[q] * rstd * lw[q] + lb[q];
            v2u o; o.x = pk2(v[q][0], v[q][1]); o.y = pk2(v[q][2], v[q][3]); *(v2u*)(x1b + (size_t)t * 1024 + 256 * q + 4 * lane) = o; }
        float lg[4];
#pragma unroll
        for (int j = 0; j < 4; ++j) { float p = 0.f;
#pragma unroll
            for (int q = 0; q < 4; ++q) { const f32x4 w = *(const LAS f32x4*)(Wl + j * RW_STRIDE + 256 * q + 4 * lane); p += (v[q][0] * w[0] + v[q][1] * w[1]) + (v[q][2] * w[2] + v[q][3] * w[3]); }
            lg[j] = wave_sum(p) + bgr[j]; }
        float m = lg[0]; int gs = 0;
#pragma unroll
        for (int j = 1; j < 4; ++j) if (lg[j] > m) { m = lg[j]; gs = j; }
        float den = 0.f;
#pragma unroll
        for (int j = 0; j < 4; ++j) den += __expf(lg[j] - m);
        const float pg = __builtin_amdgcn_rcpf(den);
        gs = __builtin_amdgcn_readfirstlane(gs);
        float el[8];
        const LAS float* We = Wl + (4 + gs * 8) * RW_STRIDE;
#pragma unroll
        for (int j = 0; j < 8; ++j) { float p = 0.f;
#pragma unroll
            for (int q = 0; q < 4; ++q) { const f32x4 w = *(const LAS f32x4*)(We + j * RW_STRIDE + 256 * q + 4 * lane); p += (v[q][0] * w[0] + v[q][1] * w[1]) + (v[q][2] * w[2] + v[q][3] * w[3]); }
            el[j] = wave_sum(p) + ber[gs * 8 + j]; }
        int i0 = 0; float v0 = el[0];
#pragma unroll
        for (int j = 1; j < 8; ++j) if (el[j] > v0) { v0 = el[j]; i0 = j; }
        int i1 = -1; float v1 = -3.0e38f;
#pragma unroll
        for (int j = 0; j < 8; ++j) if (j != i0 && el[j] > v1) { v1 = el[j]; i1 = j; }
        if (i1 < 0) i1 = (i0 == 0) ? 1 : 0;
        const float e1 = __expf(v1 - v0);
        if (lane == 0 && nb < 32) { LAS int* e = wb + nb * 8; e[0] = gs * 8 + i0; e[1] = gs * 8 + i1; e[2] = __float_as_int(pg / (1.f + e1)); e[3] = __float_as_int(pg * e1 / (1.f + e1)); e[4] = t; }
        ++nb;
    }
    route_assign(C, wb, nb < 32 ? nb : 32, cnt, lists, info);
}
__device__ __forceinline__ void p7_final(const Ctx& C, const Args& a, const LAS int* base, float* dst) {
    const bf16_t* x1 = (const bf16_t*)(a.ws + WS_X1B); const bf16_t* y = (const bf16_t*)(a.ws + WS_Y); const TokInfo* info = (const TokInfo*)(a.ws + WS_TOKINFO);
    const float* ln_w = (const float*)a.in[21]; const float* ln_b = (const float*)a.in[22];
    const int lane = C.lane;
    f32x4 lw[4], lb[4];
#pragma unroll
    for (int q = 0; q < 4; ++q) { lw[q] = *(const f32x4*)(ln_w + 256 * q + 4 * lane); lb[q] = *(const f32x4*)(ln_b + 256 * q + 4 * lane); }
    const int gw = C.vcu * NWAVES + C.wave, NGW = C.G * NWAVES;
    for (int t = gw; t < T; t += NGW) {
        const TokInfo ti = info[t];
        const bf16_t* y0 = y + (size_t)(base[ti.e0] + ti.s0) * 1024; const bf16_t* y1 = y + (size_t)(base[ti.e1] + ti.s1) * 1024;
        const bf16_t* row = x1 + (size_t)t * 1024;
        f32x4 v[4]; float s = 0.f;
#pragma unroll
        for (int q = 0; q < 4; ++q) { const int c = 256 * q + 4 * lane; const v2u a0 = *(const v2u*)(y0 + c), a1 = *(const v2u*)(y1 + c), xr = *(const v2u*)(row + c);
            v[q] = pg8::bf4_to_f32(xr.x, xr.y) * ALPHA + pg8::bf4_to_f32(a0.x, a0.y) * ti.w0 + pg8::bf4_to_f32(a1.x, a1.y) * ti.w1;
            s += (v[q][0] + v[q][1]) + (v[q][2] + v[q][3]); }
        const float mu = wave_sum(s) * (1.f / 1024.f); float sq = 0.f;
#pragma unroll
        for (int q = 0; q < 4; ++q) { v[q] = v[q] - mu; sq += (v[q][0] * v[q][0] + v[q][1] * v[q][1]) + (v[q][2] * v[q][2] + v[q][3] * v[q][3]); }
        const float rstd = rsqrtf(wave_sum(sq) * (1.f / 1024.f) + LN_EPS);
#pragma unroll
        for (int q = 0; q < 4; ++q) *(f32x4*)(dst + (size_t)t * 1024 + 256 * q + 4 * lane) = v[q] * rstd * lw[q] + lb[q];
    }
}

typedef short s16x4 __attribute__((ext_vector_type(4)));
#define MFMA32(a, b, c) __builtin_amdgcn_mfma_f32_32x32x16_bf16((a), (b), (c), 0, 0, 0)
__device__ __forceinline__ int crow(int i, int h) { return (i & 3) + 8 * (i >> 2) + 4 * h; }
__device__ __forceinline__ bf16x8 pack8(const f32x16& x, int s) {
    v4u p; p.x = pk2(x[8 * s], x[8 * s + 1]); p.y = pk2(x[8 * s + 2], x[8 * s + 3]); p.z = pk2(x[8 * s + 4], x[8 * s + 5]); p.w = pk2(x[8 * s + 6], x[8 * s + 7]);
    return __builtin_bit_cast(bf16x8, p);
}
__device__ __forceinline__ bf16x8 cvt8(const f32x4& a, const f32x4& b) { v4u p; p.x = pk2(a[0], a[1]); p.y = pk2(a[2], a[3]); p.z = pk2(b[0], b[1]); p.w = pk2(b[2], b[3]); return __builtin_bit_cast(bf16x8, p); }
__device__ __forceinline__ bf16x8 tr_frag(LAS unsigned char* img, int pitch, int k0, int k1, int mn0, int lane) {
    const int q4 = (lane & 15) >> 2, p4 = lane & 3, blk = (lane >> 4) & 1, cb = (mn0 + 16 * blk + 4 * p4) * 2;
    const s16x4 lo = __builtin_amdgcn_ds_read_tr16_b64_v4i16((LAS s16x4*)(img + (k0 + q4) * pitch + cb));
    const s16x4 hi = __builtin_amdgcn_ds_read_tr16_b64_v4i16((LAS s16x4*)(img + (k1 + q4) * pitch + cb));
    return __builtin_shufflevector(lo, hi, 0, 1, 2, 3, 4, 5, 6, 7);
}
__device__ __forceinline__ float gamma_log2(int h) { return pg8::log2_gamma(h); }

__device__ __forceinline__ void pooled_strip(const Ctx& C, const bf16_t* up, bf16_t* pooled, int strip) {
    const int cg = C.tid & 127, sub = C.tid >> 7, c = 4 * cg, w = 2 << (cg >> 5), t0 = strip * 64 + sub * 16, s0 = t0 & (SEQ - 1);
    f32x4 sum = {0.f, 0.f, 0.f, 0.f};
    for (int j = 1; j <= w; ++j) if (s0 - j >= 0) { const v2u x = *(const v2u*)(up + (size_t)(t0 - j) * 512 + c); sum += pg8::bf4_to_f32(x.x, x.y); }
#pragma unroll 4
    for (int i = 0; i < 16; ++i) { const int t = t0 + i, s = s0 + i; const v2u x = *(const v2u*)(up + (size_t)t * 512 + c); const f32x4 cur = pg8::bf4_to_f32(x.x, x.y);
        sum += cur; if (s - w >= 0) { const v2u y = *(const v2u*)(up + (size_t)(t - w) * 512 + c); sum -= pg8::bf4_to_f32(y.x, y.y); }
        const float inv = 1.f / (float)((s + 1 < w) ? s + 1 : w);
        const f32x4 o = sum * inv - cur; v2u ow; ow.x = pk2(o[0], o[1]); ow.y = pk2(o[2], o[3]); *(v2u*)(pooled + (size_t)t * 512 + c) = ow; }
}
template <bool STORE = true>
__device__ __forceinline__ void xattn_unit(const Ctx& C, bf16_t* xq, const bf16_t* mk, const bf16_t* mv, int unit) {
    const int qt = unit & 15, h = (unit >> 4) & 3, b = unit >> 6;
    LAS unsigned char* Kl = C.lds; LAS unsigned char* Vl = C.lds + 69632;
#pragma unroll
    for (int it = 0; it < 8; ++it) { const int idx = C.tid + it * 512, row = idx >> 4, ch = idx & 15;
        const size_t src = ((size_t)(b * MEML + row) * 512 + h * 128) * 2 + ch * 16;
        const v4u kv = *(const v4u*)((const char*)mk + src), vv = *(const v4u*)((const char*)mv + src);
        *(LAS v4u*)(Kl + row * 272 + ch * 16) = kv; *(LAS v4u*)(Vl + row * 320 + ch * 16) = vv; }
    __syncthreads();
    const int lane = C.lane, r = lane & 31, h2 = lane >> 5;
    bf16_t* qrow = xq + ((size_t)b * SEQ + qt * 256 + C.wave * 32 + r) * 512 + h * 128;
    bf16x8 qf[8];
#pragma unroll
    for (int ks = 0; ks < 8; ++ks) qf[ks] = *(const bf16x8*)(qrow + 16 * ks + 8 * h2);
    f32x16 ot[4];
#pragma unroll
    for (int db = 0; db < 4; ++db)
#pragma unroll
        for (int i = 0; i < 16; ++i) ot[db][i] = 0.f;
    float m_run = -3.0e38f, sum = 0.f;
#pragma unroll 1
    for (int qtr = 0; qtr < 4; ++qtr) {
        f32x16 st[2];
#pragma unroll
        for (int kq = 0; kq < 2; ++kq) { LAS unsigned char* kp = Kl + (64 * qtr + 32 * kq + r) * 272 + 16 * h2;
#pragma unroll
            for (int i = 0; i < 16; ++i) st[kq][i] = 0.f;
#pragma unroll
            for (int ks = 0; ks < 8; ++ks) { const bf16x8 kf = *(const LAS bf16x8*)(kp + 32 * ks); st[kq] = MFMA32(kf, qf[ks], st[kq]); }
        }
        float mh = -3.0e38f;
#pragma unroll
        for (int kq = 0; kq < 2; ++kq)
#pragma unroll
            for (int i = 0; i < 16; ++i) mh = fmaxf(mh, st[kq][i]);
        mh = fmaxf(mh, __shfl_xor(mh, 32));
        const float m_new = fmaxf(m_run, mh), alpha = __builtin_amdgcn_exp2f((m_run - m_new) * 1.4426950408889634f);
        sum *= alpha;
#pragma unroll
        for (int db = 0; db < 4; ++db)
#pragma unroll
            for (int i = 0; i < 16; ++i) ot[db][i] *= alpha;
        m_run = m_new;
#pragma unroll
        for (int kq = 0; kq < 2; ++kq)
#pragma unroll
            for (int i = 0; i < 16; ++i) { const float p = __builtin_amdgcn_exp2f((st[kq][i] - m_new) * 1.4426950408889634f); st[kq][i] = p; sum += p; }
#pragma unroll
        for (int kq = 0; kq < 2; ++kq)
#pragma unroll
            for (int s = 0; s < 2; ++s) { const bf16x8 pb = pack8(st[kq], s); const int k0 = 64 * qtr + 32 * kq + 16 * s + 4 * h2;
#pragma unroll
                for (int db = 0; db < 4; ++db) { const bf16x8 vf = tr_frag(Vl, 320, k0, k0 + 8, 32 * db, lane); ot[db] = MFMA32(vf, pb, ot[db]); } }
    }
    sum += __shfl_xor(sum, 32);
    const float inv = 1.f / sum;
#pragma unroll
    for (int db = 0; db < 4; ++db)
#pragma unroll
        for (int gq = 0; gq < 4; ++gq) { v2u w; w.x = pk2(ot[db][4 * gq] * inv, ot[db][4 * gq + 1] * inv); w.y = pk2(ot[db][4 * gq + 2] * inv, ot[db][4 * gq + 3] * inv);
            if (STORE) *(v2u*)(qrow + 32 * db + 8 * gq + 4 * h2) = w; else asm volatile("" :: "v"(w.x), "v"(w.y)); }
    __syncthreads();
}
template <bool WITH_K>
__device__ __forceinline__ void stage_chunk(const Ctx& C, const bf16_t* k, const bf16_t* v, size_t t0, int h) {
#pragma unroll
    for (int it = 0; it < 8; ++it) { const int idx = C.tid + it * 512, row = idx >> 5, ch = idx & 31;
        const v4u x = *(const v4u*)(v + (t0 + row) * 1024 + h * 256 + ch * 8); *(LAS v4u*)(C.lds + row * 576 + ch * 16) = x; }
    if (WITH_K) {
#pragma unroll
        for (int it = 0; it < 4; ++it) { const int idx = C.tid + it * 512, row = idx >> 4, ch = idx & 15;
            const v4u x = *(const v4u*)(k + (t0 + row) * 512 + h * 128 + ch * 8); *(LAS v4u*)(C.lds + 73728 + row * 320 + ch * 16) = x; }
    }
}
__device__ __forceinline__ void ret_state_unit(const Ctx& C, const bf16_t* k, const bf16_t* v, bf16_t* kvb, int u) {
    const int h = u & 3; const size_t t0 = (size_t)(u >> 2) * CH;
    stage_chunk<true>(C, k, v, t0, h);
    __syncthreads();
    LAS unsigned char* Vl = C.lds; LAS unsigned char* Kl = C.lds + 73728;
    const int lane = C.lane, r = lane & 31, h2 = lane >> 5, eb = C.wave;
    f32x16 acc[4];
#pragma unroll
    for (int db = 0; db < 4; ++db)
#pragma unroll
        for (int i = 0; i < 16; ++i) acc[db][i] = 0.f;
#pragma unroll
    for (int ks = 0; ks < 8; ++ks) { const int k0 = 16 * ks + 8 * h2;
        const bf16x8 bfv = tr_frag(Vl, 576, k0, k0 + 4, 32 * eb, lane);
#pragma unroll
        for (int db = 0; db < 4; ++db) { const bf16x8 afk = tr_frag(Kl, 320, k0, k0 + 4, 32 * db, lane); acc[db] = MFMA32(afk, bfv, acc[db]); } }
    const float sc = __builtin_amdgcn_exp2f((float)(CH - 1) * gamma_log2(h));
    bf16_t* out = kvb + ((size_t)u * 256 + 32 * eb + r) * 128;
#pragma unroll
    for (int db = 0; db < 4; ++db)
#pragma unroll
        for (int gq = 0; gq < 4; ++gq) { v2u w; w.x = pk2(acc[db][4 * gq] * sc, acc[db][4 * gq + 1] * sc); w.y = pk2(acc[db][4 * gq + 2] * sc, acc[db][4 * gq + 3] * sc);
            *(v2u*)(out + 32 * db + 8 * gq + 4 * h2) = w; }
    __syncthreads();
}
__device__ __forceinline__ void scan_all(const Ctx& C, const bf16_t* kvb, bf16_t* prevb, int w0, int nw) {
    const size_t nthr = (size_t)nw * NTHREADS;
    for (size_t idx = (size_t)w0 * NTHREADS + C.tid; idx < (size_t)BATCH * 4 * 8192; idx += nthr) {
        const int ed4 = (int)(idx & 8191), h = (int)((idx >> 13) & 3), b = (int)(idx >> 15);
        const float cd = __builtin_amdgcn_exp2f((float)CH * gamma_log2(h));
        v2u inc[NCH];
#pragma unroll
        for (int n = 0; n < NCH; ++n) inc[n] = *(const v2u*)(kvb + ((size_t)((b * NCH + n) * 4 + h)) * 32768 + ed4 * 4);
        f32x4 st = {0.f, 0.f, 0.f, 0.f};
#pragma unroll
        for (int n = 0; n < NCH; ++n) { v2u o; o.x = pk2(st[0], st[1]); o.y = pk2(st[2], st[3]);
            *(v2u*)(prevb + ((size_t)((b * NCH + n) * 4 + h)) * 32768 + ed4 * 4) = o; st = st * cd + pg8::bf4_to_f32(inc[n].x, inc[n].y); }
    }
}
template <bool STORE = true>
__device__ __forceinline__ void ret_out_unit(const Ctx& C, const bf16_t* q, const bf16_t* k, const bf16_t* v, const bf16_t* prevb, bf16_t* g, const float* gn_w, int u) {
    const int h = u & 3; const size_t t0 = (size_t)(u >> 2) * CH;
    stage_chunk<false>(C, k, v, t0, h);
    LAS unsigned char* Vl = C.lds; LAS unsigned char* Pl = C.lds + 73728; LAS float* red = (LAS float*)(C.lds + 73728 + 69632);
#pragma unroll
    for (int it = 0; it < 8; ++it) { const int idx = C.tid + it * 512, row = idx >> 4, ch = idx & 15;
        const v4u x = *(const v4u*)(prevb + ((size_t)u * 256 + row) * 128 + ch * 8); *(LAS v4u*)(Pl + row * 272 + ch * 16) = x; }
    __syncthreads();
    const int lane = C.lane, r = lane & 31, h2 = lane >> 5, cb = C.wave & 3, eh = C.wave >> 2;
    const size_t tokq = t0 + 32 * cb + r;
    const bf16_t* qrow = q + tokq * 512 + h * 128;
    bf16x8 qf[8];
#pragma unroll
    for (int ks = 0; ks < 8; ++ks) qf[ks] = *(const bf16x8*)(qrow + 16 * ks + 8 * h2);
    f32x16 yt[4];
#pragma unroll
    for (int el = 0; el < 4; ++el)
#pragma unroll
        for (int i = 0; i < 16; ++i) yt[el][i] = 0.f;
#pragma unroll
    for (int ks = 0; ks < 8; ++ks)
#pragma unroll
        for (int el = 0; el < 4; ++el) { const bf16x8 af = *(const LAS bf16x8*)(Pl + (32 * (4 * eh + el) + r) * 272 + (16 * ks + 8 * h2) * 2); yt[el] = MFMA32(af, qf[ks], yt[el]); }
    const float gam = __builtin_amdgcn_exp2f(gamma_log2(h));
#pragma unroll
    for (int el = 0; el < 4; ++el)
#pragma unroll
        for (int i = 0; i < 16; ++i) yt[el][i] *= gam;
    for (int sb = 0; sb <= cb; ++sb) {
        f32x16 sblk;
#pragma unroll
        for (int i = 0; i < 16; ++i) sblk[i] = 0.f;
        const bf16_t* krow = k + (t0 + 32 * sb + r) * 512 + h * 128;
#pragma unroll
        for (int ks = 0; ks < 8; ++ks) { const bf16x8 kf = *(const bf16x8*)(krow + 16 * ks + 8 * h2); sblk = MFMA32(kf, qf[ks], sblk); }
        if (sb == cb) {
#pragma unroll
            for (int i = 0; i < 16; ++i) sblk[i] = (crow(i, h2) > r) ? 0.f : sblk[i];
        }
#pragma unroll
        for (int s = 0; s < 2; ++s) { const bf16x8 pb = pack8(sblk, s); const int k0 = 32 * sb + 16 * s + 4 * h2;
#pragma unroll
            for (int el = 0; el < 4; ++el) { const bf16x8 vf = tr_frag(Vl, 576, k0, k0 + 8, 32 * (4 * eh + el), lane); yt[el] = MFMA32(vf, pb, yt[el]); } }
    }
    float s1 = 0.f;
#pragma unroll
    for (int el = 0; el < 4; ++el)
#pragma unroll
        for (int i = 0; i < 16; ++i) s1 += yt[el][i];
    s1 += __shfl_xor(s1, 32);
    if (h2 == 0) red[C.wave * 32 + r] = s1;
    __syncthreads();
    const float mean = (s1 + red[(C.wave ^ 4) * 32 + r]) * (1.f / 256.f);
    float s2 = 0.f;
#pragma unroll
    for (int el = 0; el < 4; ++el)
#pragma unroll
        for (int i = 0; i < 16; ++i) { const float d = yt[el][i] - mean; s2 += d * d; }
    s2 += __shfl_xor(s2, 32);
    if (h2 == 0) red[256 + C.wave * 32 + r] = s2;
    __syncthreads();
    const float rstd = rsqrtf((s2 + red[256 + (C.wave ^ 4) * 32 + r]) * (1.f / 256.f) + LN_EPS);
    bf16_t* grow = g + tokq * 1024 + h * 256;
#pragma unroll
    for (int el = 0; el < 4; ++el)
#pragma unroll
        for (int gq = 0; gq < 4; ++gq) { const int e0 = 32 * (4 * eh + el) + 8 * gq + 4 * h2;
            const f32x4 w = *(const f32x4*)(gn_w + h * 256 + e0); const v2u gs = *(const v2u*)(grow + e0); const f32x4 gf = pg8::bf4_to_f32(gs.x, gs.y);
            f32x4 o;
#pragma unroll
            for (int j = 0; j < 4; ++j) o[j] = (yt[el][4 * gq + j] - mean) * rstd * w[j] * gf[j];
            v2u ow; ow.x = pk2(o[0], o[1]); ow.y = pk2(o[2], o[3]); if (STORE) *(v2u*)(grow + e0) = ow; else asm volatile("" :: "v"(ow.x), "v"(ow.y)); }
    __syncthreads();
}

__global__ void __launch_bounds__(NTHREADS, 2) mega(Args a) {
    extern __shared__ __attribute__((aligned(16))) unsigned char lds_raw[];
    Ctx C; C.lds = (LAS unsigned char*)lds_raw; C.tid = threadIdx.x; C.lane = C.tid & 63; C.wave = __builtin_amdgcn_readfirstlane(C.tid >> 6);
    C.G = gridDim.x; { const int bx = blockIdx.x; C.vcu = (C.G % 8 == 0) ? (bx % 8) * (C.G / 8) + bx / 8 : bx; }
    volatile LAS unsigned* MISC = (volatile LAS unsigned*)(C.lds + MISC_OFF);
    if (C.tid < 64) MISC[C.tid] = 0u;
    __syncthreads();
    XcdBarrier bar = xcd_barrier_post((unsigned*)(a.ws + WS_CTL) + CW_BAR + a.li * XCD_BAR_WORDS, MISC + 8);
#if defined(TS_A)
#define STAMP(i) do { if (C.vcu == 0 && C.tid == 0) MISC[16 + (i)] = (unsigned)__builtin_amdgcn_s_memrealtime(); } while (0)
#else
#define STAMP(i) do {} while (0)
#endif
    STAMP(0);
    const int lo = a.ph_lo, hi = a.ph_hi;
#define IN(k) (lo <= (k) && (k) < hi)
#define BOTH(k) (IN(k) && IN((k) + 1))
    unsigned char* dout = (unsigned char*)a.out; unsigned char* ws = a.ws;
    if (IN(0)) { REP(0) p0_prologue(C, a); if (BOTH(0)) xcd_barrier(bar); STAMP(1); }
    if (IN(1)) {
        REP(1) { pg8::Gemm g{(const bf16_t*)(dout + DO_XB), (const bf16_t*)(dout + DO_WINT), T, NIN, 1024}; pg8::StaticOrder S; S.init(T, NIN, C.G, (int)blockIdx.x);
          pg8::EpiProj E{(bf16_t*)(ws + WS_UPOOL), (bf16_t*)(ws + WS_Q), (bf16_t*)(ws + WS_K), (bf16_t*)(ws + WS_V), (bf16_t*)(ws + WS_G), (bf16_t*)(ws + WS_XQ), (bf16_t*)(ws + WS_GATES), (const float*)(dout + DO_CS)};
          pg8::gemm_phase<pg8::EpiProj, pg8::StaticOrder, true, true>(C.lds, g, S, E); }
        if (BOTH(1)) xcd_barrier(bar); STAMP(2);
    }
    if (IN(2)) {
        const int nh = (C.G >= 64) ? 16 : 0;
        if (C.vcu < nh || nh == 0) {
            pg8::Gemm g{(const bf16_t*)(ws + WS_MEMB), (const bf16_t*)(ws + WS_WMEMT), BATCH * MEML, 1024, 1024}; pg8::StaticOrder S; S.init(BATCH * MEML, 1024, nh ? nh : C.G, C.vcu);
            pg8::EpiMemKV E{(bf16_t*)(ws + WS_MEMK), (bf16_t*)(ws + WS_MEMV)};
            pg8::gemm_phase<pg8::EpiMemKV, pg8::StaticOrder, true, true>(C.lds, g, S, E);
        }
        if (C.vcu >= nh) {
            const int w0 = C.vcu - nh, nw = C.G - nh;
            for (int s = w0; s < T / 64; s += nw) pooled_strip(C, (const bf16_t*)(ws + WS_UPOOL), (bf16_t*)(ws + WS_POOLED), s);
            for (int u = w0; u < BATCH * NCH * 4; u += nw) ret_state_unit(C, (const bf16_t*)(ws + WS_K), (const bf16_t*)(ws + WS_V), (bf16_t*)dout, u);
        }
        if (BOTH(2)) xcd_barrier(bar); STAMP(3);
    }
    if (IN(3)) {
        for (int u = C.vcu; u < BATCH * 4 * (SEQ / 256); u += C.G) xattn_unit(C, (bf16_t*)(ws + WS_XQ), (const bf16_t*)(ws + WS_MEMK), (const bf16_t*)(ws + WS_MEMV), u);
        const int nh = (C.G >= 64) ? C.G / 2 : 0;
        if (C.vcu < nh || nh == 0) {
            pg8::Gemm g{(const bf16_t*)(ws + WS_POOLED), (const bf16_t*)(ws + WS_WPOOLBD), T, 512, 512}; pg8::StaticOrder S; S.init(T, 512, nh ? nh : C.G, C.vcu);
            pg8::EpiPoolMap E{(bf16_t*)(ws + WS_UPOOL), (const float*)a.in[5]};
            pg8::gemm_phase<pg8::EpiPoolMap, pg8::StaticOrder, true, true>(C.lds, g, S, E);
        }
        if (C.vcu >= nh) scan_all(C, (const bf16_t*)dout, (bf16_t*)(dout + 32 * MiB), C.vcu - nh, C.G - nh);
        if (BOTH(3)) xcd_barrier(bar); STAMP(4);
    }
    if (IN(4)) {
        for (int u = C.vcu; u < BATCH * NCH * 4; u += C.G) ret_out_unit(C, (const bf16_t*)(ws + WS_Q), (const bf16_t*)(ws + WS_K), (const bf16_t*)(ws + WS_V), (const bf16_t*)(dout + 32 * MiB), (bf16_t*)(ws + WS_G), (const float*)a.in[6], u);
        if (BOTH(4)) xcd_barrier(bar); STAMP(5);
    }
    if (IN(5)) {
        const bf16_t* gates = (const bf16_t*)(ws + WS_GATES); bf16_t* merged = (bf16_t*)(ws + WS_MERGED);
        pg8::StaticOrder S; S.init(T, 1024, C.G, (int)blockIdx.x);
        for (int step = 0; step < 3; ++step) {
            const int sel = (C.vcu & 1) ? (step + 1) % 3 : step;
            const bf16_t* Ap = (const bf16_t*)(ws + (sel == 0 ? WS_UPOOL : sel == 1 ? WS_G : WS_XQ));
            const bf16_t* Bp = (const bf16_t*)(ws + (sel == 0 ? WS_WPT : sel == 1 ? WS_WRT : WS_WXT));
            pg8::Gemm g{Ap, Bp, T, 1024, sel == 1 ? 1024 : 512}; pg8::EpiGate E{merged, (bf16_t*)dout, gates, sel, step};
            if (step) __builtin_amdgcn_fence(__ATOMIC_ACQUIRE, "agent");
            pg8::gemm_phase<pg8::EpiGate, pg8::StaticOrder, true, true>(C.lds, g, S, E);
        }
        if (BOTH(5)) xcd_barrier(bar); STAMP(6);
    }
    if (IN(6)) {
        pg8::Gemm g{(const bf16_t*)(ws + WS_MERGED), (const bf16_t*)(ws + WS_WOUTT), T, 1024, 1024}; pg8::StaticOrder S; S.init(T, 1024, C.G, (int)blockIdx.x);
        pg8::EpiResid E{(bf16_t*)dout, (const float*)a.in[0]};
        REP(6) pg8::gemm_phase<pg8::EpiResid, pg8::StaticOrder, true, true>(C.lds, g, S, E);
        if (BOTH(6)) xcd_barrier(bar); STAMP(7);
    }
    if (IN(7)) {
        moe_convert_weights(C, a);
        __syncthreads(); STAMP(12);
        p5_stage_router(C, a); STAMP(13);
        p5_ln1_router(C, a);
        if (BOTH(7)) xcd_barrier(bar); STAMP(8);
    }
    LAS int* mbase = (LAS int*)(C.lds + RING_BYTES);
    const int* cntp = (const int*)(ws + WS_CTL) + CW_CNT;
    if (IN(8)) {
        compute_base(C, cntp, mbase);
        pg8::MoeSched<true> S{mbase, cntp, (const int*)(ws + WS_LISTS), (const char*)(ws + WS_X1B), (const char*)(ws + WS_MOEW1), (size_t)512 * 1024 * 2, 1024, 2, C.G, C.vcu};
        pg8::EpiMoeAct E{(bf16_t*)(ws + WS_ACT)};
        REP(8) pg8::gemm_phase_g<pg8::EpiMoeAct, pg8::MoeSched<true>>(C.lds, 1024, S, E);
        if (BOTH(8)) xcd_barrier(bar); STAMP(9);
    }
    if (IN(9)) {
        compute_base(C, cntp, mbase);
        pg8::Gemm g{(const bf16_t*)(ws + WS_ACT), (const bf16_t*)(ws + WS_MOEW2), 40960, 32 * 1024, 256}; pg8::MoeOrder S{mbase, 4, C.G, C.vcu};
        pg8::EpiMoeY E{(bf16_t*)(ws + WS_Y)};
        REP(9) pg8::gemm_phase<pg8::EpiMoeY, pg8::MoeOrder, true, true>(C.lds, g, S, E);
        if (BOTH(9)) xcd_barrier(bar); STAMP(10);
    }
    if (IN(10)) {
        compute_base(C, cntp, mbase);
        p7_final(C, a, mbase, a.out);
        STAMP(11);
#if defined(TS_A)
        __syncthreads();
        if (C.vcu == 0 && C.tid == 0) { const unsigned d = MISC[16 + TS_B] - MISC[16 + TS_A]; a.out[0] += (float)(TS_SCALE) * (float)d; }
#endif
    }
#undef IN
#undef BOTH
}

static int g_grid = 0;
static void launch_mega(hipStream_t stream, Args a, int lo, int hi, int li) {
    a.ph_lo = lo; a.ph_hi = hi; a.li = li; a.pad = 0;
    hipLaunchKernelGGL(mega, dim3(g_grid), dim3(NTHREADS), LDS_BYTES, stream, a);
    const hipError_t e = hipPeekAtLastError();
    if (e != hipSuccess) fprintf(stderr, "kernel_launch: launch failed: %s (grid %d)\n", hipGetErrorString(e), g_grid);
}

extern "C" void kernel_launch(void* const* d_in, const int* in_sizes, int n_in, void* d_out, int out_size, void* d_ws, size_t ws_size, hipStream_t stream) {
    if (g_grid == 0) {
        int dev = 0, cus = 0, per_cu = 0;
        (void)hipGetDevice(&dev); (void)hipDeviceGetAttribute(&cus, hipDeviceAttributeMultiprocessorCount, dev);
        (void)hipFuncSetAttribute((const void*)mega, hipFuncAttributeMaxDynamicSharedMemorySize, LDS_BYTES);
        (void)hipOccupancyMaxActiveBlocksPerMultiprocessor(&per_cu, (const void*)mega, NTHREADS, LDS_BYTES);
        if (per_cu < 1) { fprintf(stderr, "kernel_launch: occupancy query reports %d blocks per CU\n", per_cu); per_cu = 1; }
        g_grid = cus;
    }
    Args a{}; for (int i = 0; i < 23; ++i) a.in[i] = d_in[i]; a.out = (float*)d_out; a.ws = (unsigned char*)d_ws;
    (void)hipMemsetAsync((unsigned char*)d_ws + WS_CTL, 0, 32768, stream);
    launch_mega(stream, a, 0, 11, 0);
}
```
